# Optimizing an MI355X kernel written in HIP

```python
import jax, jax.numpy as jnp
from jax import lax
import numpy as np

D_MODEL = 2048
BATCH = 4
SEQ = 2048
DEPTH = 2
DEC_BATCH = 128
DEC_SEQ = 1
PAST_LEN = 16384
PAGE_SIZE = 128

MIX_WIDTH = D_MODEL
N_MIXERS = 4
GROUP_WIDTH = MIX_WIDTH // N_MIXERS
POOL_WINDOWS = (2, 4, 8, 16)
POOL_GROUPS = len(POOL_WINDOWS)
POOL_CH = GROUP_WIDTH // POOL_GROUPS
POOL_BUF = max(POOL_WINDOWS) - 1
CONV_WIDTH = 3
RET_HEADS = 4
RET_HEAD_DIM = GROUP_WIDTH // RET_HEADS
RET_CHUNK = 128
ROPE_BASE = 10000.0
SGU_HEADS = 4
SGU_CH = GROUP_WIDTH // SGU_HEADS
SGU_CHUNK = 128
D_FF = ((8 * D_MODEL + 3 * 256 - 1) // (3 * 256)) * 256
IN_WIDTH = 10 * GROUP_WIDTH
NORM_EPS = 1e-6

kernel_name = 'hybrid_pool_conv_retention_sgu_step'


def rmsnorm(x, g):
    xf = x.astype(jnp.float32)
    y = xf * lax.rsqrt(jnp.mean(xf * xf, axis=-1, keepdims=True) + NORM_EPS)
    return (y * g.astype(jnp.float32)).astype(x.dtype)


def layernorm_f32(x):
    xf = x.astype(jnp.float32)
    mu = jnp.mean(xf, axis=-1, keepdims=True)
    xc = xf - mu
    return xc * lax.rsqrt(jnp.mean(xc * xc, axis=-1, keepdims=True) + NORM_EPS)


def pool_mixer(a, prev, start, w, scale):
    B, L, _ = a.shape
    ext = jnp.concatenate([prev.astype(a.dtype), a], axis=1).astype(jnp.float32)
    cs = jnp.pad(jnp.cumsum(ext, axis=1), ((0, 0), (1, 0), (0, 0)))
    end = cs[:, POOL_BUF + 1:]
    pos = start + jnp.arange(L)
    af = a.astype(jnp.float32)
    outs = []
    for gi, win in enumerate(POOL_WINDOWS):
        sl = slice(gi * POOL_CH, (gi + 1) * POOL_CH)
        lo = POOL_BUF + 1 - win
        wsum = end[..., sl] - cs[:, lo:lo + L, sl]
        cnt = jnp.minimum(pos + 1, win).astype(jnp.float32)[None, :, None]
        d = (wsum / cnt - af[..., sl]).astype(a.dtype)
        outs.append(jnp.einsum('blc,ce->ble', d, w[gi]))
    y = jnp.concatenate(outs, axis=-1) * scale
    return y, ext[:, -POOL_BUF:].astype(a.dtype)


def conv_mixer(bg, cg, hh, prev, w):
    z = cg * hh
    L = z.shape[1]
    ext = jnp.concatenate([prev.astype(z.dtype), z], axis=1)
    acc = ext[:, 0:L] * w[0]
    for kk in range(1, CONV_WIDTH):
        acc = acc + ext[:, kk:kk + L] * w[kk]
    return bg * acc, ext[:, -(CONV_WIDTH - 1):]


def rotary(x, pos):
    half = x.shape[-1] // 2
    inv = ROPE_BASE ** (-jnp.arange(half, dtype=jnp.float32) / half)
    ang = pos.astype(jnp.float32)[:, None] * inv[None, :]
    cos = jnp.cos(ang)[None, :, None, :]
    sin = jnp.sin(ang)[None, :, None, :]
    x1, x2 = x[..., :half], x[..., half:]
    return jnp.concatenate([x1 * cos - x2 * sin, x2 * cos + x1 * sin], axis=-1)


def retention(q, k, v, S0, start):
    B, L, _ = q.shape
    H, d = RET_HEADS, RET_HEAD_DIM
    pos = start + jnp.arange(L)
    f = lambda t: t.astype(jnp.float32).reshape(B, L, H, d)
    q = rotary(f(q), pos)
    k = rotary(f(k), pos) * (d ** -0.5)
    v = f(v)
    c = RET_CHUNK if L % RET_CHUNK == 0 else L
    n = L // c
    chunks = lambda t: t.reshape(B, n, c, H, d).transpose(1, 0, 3, 2, 4)
    lg = jnp.log1p(-(2.0 ** (-5.0 - jnp.arange(H, dtype=jnp.float32))))
    idx = jnp.arange(c, dtype=jnp.float32)
    diff = idx[:, None] - idx[None, :]
    decay_mask = jnp.where(diff >= 0, jnp.exp(jnp.maximum(diff, 0.0)[None] * lg[:, None, None]), 0.0)
    q_decay = jnp.exp((idx + 1.0)[None, :] * lg[:, None])[:, :, None]
    k_decay = jnp.exp((c - 1.0 - idx)[None, :] * lg[:, None])[:, :, None]
    chunk_decay = jnp.exp(c * lg)[:, None, None]

    def step(S, qkv):
        qc, kc, vc = qkv
        scores = jnp.einsum('bhid,bhjd->bhij', qc, kc) * decay_mask
        o = jnp.einsum('bhij,bhje->bhie', scores, vc) + jnp.einsum('bhid,bhde->bhie', qc * q_decay, S)
        S = chunk_decay * S + jnp.einsum('bhjd,bhje->bhde', kc * k_decay, vc)
        return S, o

    S, o = lax.scan(step, S0.astype(jnp.float32), (chunks(q), chunks(k), chunks(v)))
    o = o.transpose(1, 0, 3, 2, 4).reshape(B, L, H, d)
    return o, S


def sgu_mixer(u, v, w_s, b_s, norm_g):
    B, L, _ = u.shape
    vn = layernorm_f32(v) * norm_g.astype(jnp.float32)
    c = L if L <= SGU_CHUNK else SGU_CHUNK
    Lp = -(-L // c) * c
    vp = jnp.pad(vn, ((0, 0), (0, Lp - L), (0, 0))).reshape(B, Lp // c, c, SGU_HEADS, SGU_CH)
    tri = jnp.tril(jnp.ones((c, c), dtype=bool))
    w = jnp.where(tri[None], w_s[:, :c, :c].astype(jnp.float32), 0.0)
    bias = b_s[:, :c].astype(jnp.float32).T[None, None, :, :, None]
    mixed = jnp.einsum('hts,bnshe->bnthe', w, vp) + bias
    mixed = mixed.reshape(B, Lp, GROUP_WIDTH)[:, :L]
    y = (u.astype(jnp.float32) * mixed).astype(u.dtype)
    n_open = (L - 1) % SGU_CHUNK + 1
    return y, vn[:, L - n_open:].astype(u.dtype)


def decoder_layer(h, start, pool_prev, conv_prev, ret_prev,
                  norm1_g, w_in, pool_w, pool_scale, conv_w, ret_norm_g,
                  sgu_norm_g, sgu_w, sgu_b, w_out, norm2_g, w_gate_up, w_down):
    B, L, _ = h.shape
    xn = rmsnorm(h, norm1_g)
    p = jnp.einsum('bld,de->ble', xn, w_in)
    a, bg, cg, hh, q, k, v, g, u, vv = jnp.split(p, 10, axis=-1)
    y_a, pool_new = pool_mixer(a, pool_prev, start, pool_w, pool_scale)
    y_b, conv_new = conv_mixer(bg, cg, hh, conv_prev, conv_w)
    o, ret_new = retention(q, k, v, ret_prev, start)
    on = layernorm_f32(o).reshape(B, L, GROUP_WIDTH) * ret_norm_g.astype(jnp.float32)
    y_c = (jax.nn.silu(g.astype(jnp.float32)) * on).astype(h.dtype)
    y_d, sgu_rows = sgu_mixer(u, vv, sgu_w, sgu_b, sgu_norm_g)
    mix = jnp.concatenate([y_a, y_b, y_c, y_d], axis=-1)
    h = h + jnp.einsum('blm,md->bld', mix, w_out)
    hn = rmsnorm(h, norm2_g)
    gt, up = jnp.split(jnp.einsum('bld,df->blf', hn, w_gate_up), 2, axis=-1)
    h = h + jnp.einsum('blf,fd->bld', jax.nn.silu(gt) * up, w_down)
    return h, pool_new, conv_new, ret_new, sgu_rows


def setup_inputs(seed: int = 0) -> dict:
    key = jax.random.key(seed)
    ks = jax.random.split(key, 20)
    f32 = jnp.float32
    nrm = lambda k, shape, s: jax.random.normal(k, shape, f32) * s
    return {
        'x_prompt': nrm(ks[0], (BATCH, SEQ, D_MODEL), 1.0),
        'x_sample': nrm(ks[1], (DEC_BATCH, DEC_SEQ, D_MODEL), 1.0),
        'state_pool': nrm(ks[2], (DEPTH, DEC_BATCH, POOL_BUF, GROUP_WIDTH), 1.0),
        'state_conv': nrm(ks[3], (DEPTH, DEC_BATCH, CONV_WIDTH - 1, GROUP_WIDTH), 1.0),
        'state_ret': nrm(ks[4], (DEPTH, DEC_BATCH, RET_HEADS, RET_HEAD_DIM, RET_HEAD_DIM), 0.5),
        'norm1_g': 1.0 + nrm(ks[5], (DEPTH, D_MODEL), 0.02),
        'w_in': nrm(ks[6], (DEPTH, D_MODEL, IN_WIDTH), D_MODEL ** -0.5),
        'pool_w': nrm(ks[7], (DEPTH, POOL_GROUPS, POOL_CH, POOL_CH), POOL_CH ** -0.5),
        'pool_scale': 1.0 + nrm(ks[8], (DEPTH, GROUP_WIDTH), 0.02),
        'conv_w': nrm(ks[9], (DEPTH, CONV_WIDTH, GROUP_WIDTH), CONV_WIDTH ** -0.5),
        'ret_norm_g': 1.0 + nrm(ks[10], (DEPTH, GROUP_WIDTH), 0.02),
        'sgu_norm_g': 1.0 + nrm(ks[11], (DEPTH, GROUP_WIDTH), 0.02),
        'sgu_w': nrm(ks[12], (DEPTH, SGU_HEADS, SGU_CHUNK, SGU_CHUNK), SGU_CHUNK ** -0.5),
        'sgu_b': 1.0 + nrm(ks[13], (DEPTH, SGU_HEADS, SGU_CHUNK), 0.02),
        'w_out': nrm(ks[14], (DEPTH, MIX_WIDTH, D_MODEL), MIX_WIDTH ** -0.5),
        'norm2_g': 1.0 + nrm(ks[15], (DEPTH, D_MODEL), 0.02),
        'w_gate_up': nrm(ks[16], (DEPTH, D_MODEL, 2 * D_FF), D_MODEL ** -0.5),
        'w_down': nrm(ks[17], (DEPTH, D_FF, D_MODEL), D_FF ** -0.5),
        'final_norm_g': 1.0 + nrm(ks[18], (D_MODEL,), 0.02),
    }


def reference(x_prompt, x_sample, state_pool, state_conv, state_ret,
              norm1_g, w_in, pool_w, pool_scale, conv_w, ret_norm_g,
              sgu_norm_g, sgu_w, sgu_b, w_out, norm2_g, w_gate_up, w_down, final_norm_g):
    hp, hs = x_prompt, x_sample
    Bp = x_prompt.shape[0]
    pool_p, pool_s, conv_p, conv_s, ret_p, ret_s, sgu_p, sgu_s = [], [], [], [], [], [], [], []
    for l in range(DEPTH):
        lp = (norm1_g[l], w_in[l], pool_w[l], pool_scale[l], conv_w[l], ret_norm_g[l],
              sgu_norm_g[l], sgu_w[l], sgu_b[l], w_out[l], norm2_g[l], w_gate_up[l], w_down[l])
        hp, a1, b1, c1, d1 = decoder_layer(
            hp, 0,
            jnp.zeros((Bp, POOL_BUF, GROUP_WIDTH), x_prompt.dtype),
            jnp.zeros((Bp, CONV_WIDTH - 1, GROUP_WIDTH), x_prompt.dtype),
            jnp.zeros((Bp, RET_HEADS, RET_HEAD_DIM, RET_HEAD_DIM), jnp.float32),
            *lp)
        hs, a2, b2, c2, d2 = decoder_layer(hs, PAST_LEN, state_pool[l], state_conv[l], state_ret[l], *lp)
        pool_p.append(a1); conv_p.append(b1); ret_p.append(c1); sgu_p.append(d1)
        pool_s.append(a2); conv_s.append(b2); ret_s.append(c2); sgu_s.append(d2)
    y_prompt = rmsnorm(hp, final_norm_g)
    y_sample = rmsnorm(hs, final_norm_g)
    return (y_prompt, y_sample,
            jnp.stack(pool_p), jnp.stack(pool_s),
            jnp.stack(conv_p), jnp.stack(conv_s),
            jnp.stack(ret_p), jnp.stack(ret_s),
            jnp.stack(sgu_p), jnp.stack(sgu_s))
```

```cpp
#include <hip/hip_runtime.h>
#include <cstdio>
#include <cstdint>

#ifndef MK_N_LAUNCHES
#define MK_N_LAUNCHES 1
#endif

#define LAS __attribute__((address_space(3)))
#define GAS __attribute__((address_space(1)))
#define DI __device__ __forceinline__

typedef unsigned short bf16_t;
typedef short bf16x8 __attribute__((ext_vector_type(8)));
typedef short s16x4 __attribute__((ext_vector_type(4)));
typedef float f32x4 __attribute__((ext_vector_type(4)));
typedef float f32x2 __attribute__((ext_vector_type(2)));
typedef unsigned u32x4 __attribute__((ext_vector_type(4)));
typedef unsigned u32x2 __attribute__((ext_vector_type(2)));
typedef __bf16 bf16x2_t __attribute__((ext_vector_type(2)));

constexpr int D = 2048, INW = 5120, FF = 5632, GU = 2 * FF;
constexpr int NB = 4, SEQ = 2048, MPR = NB * SEQ  , NS = 128, MV = MPR + NS  , MP = 8448  ;
constexpr int DEPTH = 2, NCH = SEQ / 128  ;
constexpr int C_A = 0, C_BG = 512, C_CG = 1024, C_HH = 1536, C_Q = 2048, C_K = 2560, C_V = 3072, C_G = 3584, C_U = 4096, C_VV = 4608;
constexpr float NORM_EPS = 1e-6f;
constexpr int ROPE_SPOS = 2048;
constexpr size_t O_YP = 0, O_YS = 16777216, O_POOLP = 17039360, O_POOLS = 17100800, O_CONVP = 19066880, O_CONVS = 19075072,
                 O_RETP = 19337216, O_RETS = 19861504, O_SGUP = 36638720, O_SGUS = 37163008, O_END = 37294080;

constexpr size_t MiB = 1u << 20;
constexpr size_t WS_CTL = 0, CTL_ZERO_BYTES = 1 * MiB;
constexpr size_t WS_ROPE = 1 * MiB;
constexpr size_t WS_POOLW = 3 * MiB;
constexpr size_t WS_SGUW = 4 * MiB;
constexpr size_t WS_SSQ1 = 5 * MiB, WS_SSQ2 = 6 * MiB;
constexpr size_t WS_WIN = 8 * MiB;
constexpr size_t WS_WOUT = 48 * MiB;
constexpr size_t WS_WGU = 64 * MiB;
constexpr size_t WS_WDN = 152 * MiB;
constexpr size_t WS_H = 196 * MiB;
constexpr size_t WS_HB = 262 * MiB;
constexpr size_t WS_PB = 295 * MiB;
constexpr size_t WS_MIX = 378 * MiB;
constexpr size_t WS_ACT = 411 * MiB;
constexpr size_t WS_KV = 502 * MiB;
constexpr size_t WS_END = 518 * MiB;
constexpr int CW_BAR = 4096;

constexpr int RING_BYTES = 131072;
constexpr int MISC_OFF = RING_BYTES;
constexpr int LDSCTL_OFF = MISC_OFF + 4096;
constexpr int LDS_BYTES = 147456;

DI float bf2f(unsigned short b) { return __uint_as_float(((unsigned)b) << 16); }
DI float bflo(unsigned w) { return __uint_as_float(w << 16); }
DI float bfhi(unsigned w) { return __uint_as_float(w & 0xffff0000u); }
DI unsigned pk2(float lo, float hi) { f32x2 v = {lo, hi}; bf16x2_t b = __builtin_convertvector(v, bf16x2_t); return __builtin_bit_cast(unsigned, b); }
DI float wave_sum(float v) {
#pragma unroll
    for (int o = 1; o < 64; o <<= 1) v += __shfl_xor(v, o);
    return v;
}
DI float silu_f(float g) { return g / (1.0f + __expf(-g)); }
DI int opaque_tid() { int t = threadIdx.x; asm volatile("" : "+v"(t)); return t; }

namespace pg8 {
constexpr int BM = 256, BK = 64, HALF = 128, HTB = HALF * BK * 2  , STAGE_BYTES = 8 * HTB, NXCD = 8, WGM = 8;
__host__ __device__ __forceinline__ int lds_byte(int r, int c) { const int st = (r >> 4) * 2 + (c >> 5), rr = r & 15, cc = c & 31, ob = rr * 64 + cc * 2; return st * 1024 + (ob ^ (((ob >> 9) & 1) << 5)); }
__host__ __device__ __forceinline__ void stage_rc(int b, int& R, int& C) { const int st = b / 1024, sb = b % 1024, swz = sb ^ (((sb >> 9) & 1) << 5); R = (st >> 1) * 16 + swz / 64; C = (st & 1) * 32 + (swz % 64) / 2; }
__host__ __device__ __forceinline__ int perm32(int rho) { const int n = rho >> 4, i = rho & 15; return 8 * (i >> 2) + 4 * n + (i & 3); }

struct Unit { int pm, pn; };
struct Gemm { const bf16_t* A; const bf16_t* Bt; int M, N, K; };

struct StaticOrder {
    int nM, nN, nwg, G, c;
    __host__ __device__ void init(int M, int N, int G_, int c_) { nM = M / BM; nN = N / BM; nwg = nM * nN; G = G_; c = c_; }
    __host__ __device__ bool next(int i, Unit& u) const {
        const long L = (long)i * G + c; if (L >= nwg) return false;
        int wgid = (int)L; { const int q = nwg / NXCD, r = nwg % NXCD, xcd = wgid % NXCD, off = wgid / NXCD; wgid = (xcd < r ? xcd * (q + 1) : r * (q + 1) + (xcd - r) * q) + off; }
        const int nig = WGM * nN, gid = wgid / nig, fm = gid * WGM, gsz = (nM - fm) < WGM ? (nM - fm) : WGM;
        u.pm = fm + ((wgid % nig) % gsz); u.pn = (wgid % nig) / gsz; return true;
    }
    __device__ __forceinline__ void a_ready(const Unit&) const {}
    __device__ __forceinline__ void done(const Unit&) const {}
};

DI float row_rstd(const float* ssq, int row) {
    const f32x4 s0 = *(const f32x4*)(ssq + (size_t)row * 8), s1 = *(const f32x4*)(ssq + (size_t)row * 8 + 4);
    const float ss = ((s0[0] + s0[1]) + (s0[2] + s0[3])) + ((s1[0] + s1[1]) + (s1[2] + s1[3]));
    return 1.0f / sqrtf(ss * (1.0f / (float)D) + NORM_EPS);
}
struct EpiIn {
    static constexpr bool PERM = true;
    bf16_t* P; const float* ssq;
    DI void operator()(const f32x4 (&acc)[2][2][4][2], const Unit& u, int wr, int wc, int fr, int fq, LAS unsigned char*, int) const {
        const int row0 = u.pm * BM + wr * 64 + fr, col0 = u.pn * BM + wc * 32 + 8 * fq;
#pragma unroll
        for (int ai = 0; ai < 2; ++ai)
#pragma unroll
            for (int m = 0; m < 4; ++m) { const int row = row0 + ai * HALF + m * 16;
                if (row < MV) { const float rs = row_rstd(ssq, row); bf16_t* rowp = P + (size_t)row * INW + col0;
#pragma unroll
                    for (int bj = 0; bj < 2; ++bj) { const f32x4 v0 = acc[ai][bj][m][0] * rs, v1 = acc[ai][bj][m][1] * rs;
                        u32x4 w; w.x = pk2(v0[0], v0[1]); w.y = pk2(v0[2], v0[3]); w.z = pk2(v1[0], v1[1]); w.w = pk2(v1[2], v1[3]);
                        *(u32x4*)(rowp + bj * HALF) = w; } } }
    }
};
struct EpiGu {
    static constexpr bool PERM = true;
    bf16_t* ACT; const float* ssq;
    DI void operator()(const f32x4 (&acc)[2][2][4][2], const Unit& u, int wr, int wc, int fr, int fq, LAS unsigned char*, int) const {
        const int row0 = u.pm * BM + wr * 64 + fr, col0 = u.pn * HALF + wc * 32 + 8 * fq;
#pragma unroll
        for (int ai = 0; ai < 2; ++ai)
#pragma unroll
            for (int m = 0; m < 4; ++m) { const int row = row0 + ai * HALF + m * 16;
                if (row < MV) { const float rs = row_rstd(ssq, row);
                    float o[8];
#pragma unroll
                    for (int n = 0; n < 2; ++n)
#pragma unroll
                        for (int j = 0; j < 4; ++j) { const float g = acc[ai][0][m][n][j] * rs, up = acc[ai][1][m][n][j] * rs; o[n * 4 + j] = silu_f(g) * up; }
                    u32x4 w; w.x = pk2(o[0], o[1]); w.y = pk2(o[2], o[3]); w.z = pk2(o[4], o[5]); w.w = pk2(o[6], o[7]);
                    *(u32x4*)(ACT + (size_t)row * FF + col0) = w; } }
    }
};
struct EpiRes {
    static constexpr bool PERM = true;
    const float* base_p; const float* base_s;
    float* H; bf16_t* HB; float* ssq_out;
    DI void operator()(const f32x4 (&acc)[2][2][4][2], const Unit& u, int wr, int wc, int fr, int fq, LAS unsigned char* misc, int tid) const {
        LAS float* part = (LAS float*)misc;
        const int col0 = u.pn * BM + wc * 32 + 8 * fq;
#pragma unroll
        for (int ai = 0; ai < 2; ++ai)
#pragma unroll
            for (int m = 0; m < 4; ++m) { const int rl = ai * HALF + wr * 64 + m * 16 + fr, row = u.pm * BM + rl; float ss = 0.f;
                if (row < MV) { const size_t off = (size_t)row * D + col0; const float* bp = (row < MPR ? base_p : base_s) + off;
#pragma unroll
                    for (int bj = 0; bj < 2; ++bj) { const f32x4 b0 = *(const f32x4*)(bp + bj * HALF), b1 = *(const f32x4*)(bp + bj * HALF + 4);
                        const f32x4 h0 = b0 + acc[ai][bj][m][0], h1 = b1 + acc[ai][bj][m][1];
                        *(f32x4*)(H + off + bj * HALF) = h0; *(f32x4*)(H + off + bj * HALF + 4) = h1;
                        u32x4 w; w.x = pk2(h0[0], h0[1]); w.y = pk2(h0[2], h0[3]); w.z = pk2(h1[0], h1[1]); w.w = pk2(h1[2], h1[3]);
                        *(u32x4*)(HB + off + bj * HALF) = w;
                        ss += ((h0[0] * h0[0] + h0[1] * h0[1]) + (h0[2] * h0[2] + h0[3] * h0[3])) + ((h1[0] * h1[0] + h1[1] * h1[1]) + (h1[2] * h1[2] + h1[3] * h1[3])); } }
                ss += __shfl_xor(ss, 16); ss += __shfl_xor(ss, 32);
                if (fq == 0) part[rl * 4 + wc] = ss; }
        asm volatile("s_waitcnt lgkmcnt(0)" ::: "memory"); __builtin_amdgcn_s_barrier(); asm volatile("" ::: "memory");
        if (tid < 256) { const int row = u.pm * BM + tid; const LAS f32x4* p4 = (const LAS f32x4*)(part + tid * 4); const f32x4 p = *p4;
            if (row < MV) __hip_atomic_store(ssq_out + (size_t)row * 8 + u.pn, (p[0] + p[1]) + (p[2] + p[3]), __ATOMIC_RELAXED, __HIP_MEMORY_SCOPE_AGENT); }
    }
};

template <class Epi, class Sched, bool ALIGN_EPI, bool SP2>
__device__ __forceinline__ void gemm_phase(LAS unsigned char* lds, LAS unsigned char* misc, const Gemm g, const Sched& S, const Epi& E) {
    const int tid = opaque_tid(), wid = __builtin_amdgcn_readfirstlane(tid >> 6), lane = tid & 63, wr = wid >> 2, wc = wid & 3, fr = lane & 15, fq = lane >> 4;
    const int K = g.K, nt = K / BK;
    unsigned voffA[2], voffB[2];
#pragma unroll
    for (int i = 0; i < 2; ++i) { int R, C; stage_rc(tid * 16 + i * 8192, R, C); const int Rb = Epi::PERM ? ((R & ~31) + perm32(R & 31)) : R;
        voffA[i] = (unsigned)(R * K + C) * 2u; voffB[i] = (unsigned)(Rb * K + C) * 2u; }
    const size_t kstep = (size_t)(BK * 2);
    const size_t hstep = (size_t)HALF * K * 2;
    const size_t tstep = 2 * hstep;
    const unsigned ldsw = (unsigned)wid * 1024u;
    const int aoff = lds_byte(wr * 64 + fr, fq * 8), boff = lds_byte(wc * 32 + fr, fq * 8);
#define PG8_SA(b, h) (((b) * 2 + (h)) * HTB)
#define PG8_SB(b, h) ((4 + (b) * 2 + (h)) * HTB)
#define PG8_STAGE(bufoff, gbase, voff) do { _Pragma("unroll") for (int _i = 0; _i < 2; ++_i) \
        __builtin_amdgcn_global_load_lds((const unsigned*)((const char*)(gbase) + (voff)[_i]), (LAS unsigned*)(lds + (bufoff) + ldsw + _i * 8192), 16, 0, 0); } while (0)
#define PG8_LDA(dst, b, h) do { _Pragma("unroll") for (int m = 0; m < 4; ++m) _Pragma("unroll") for (int k = 0; k < 2; ++k) dst[m][k] = *(const LAS bf16x8*)(lds + PG8_SA(b, h) + aoff + m * 2048 + k * 1024); } while (0)
#define PG8_LDB(dst, b, h) do { _Pragma("unroll") for (int n = 0; n < 2; ++n) _Pragma("unroll") for (int k = 0; k < 2; ++k) dst[n][k] = *(const LAS bf16x8*)(lds + PG8_SB(b, h) + boff + n * 2048 + k * 1024); } while (0)
#define PG8_MMA(ai, bj, At, Bt) do { __builtin_amdgcn_s_setprio(1); _Pragma("unroll") for (int m = 0; m < 4; ++m) _Pragma("unroll") for (int n = 0; n < 2; ++n) _Pragma("unroll") for (int k = 0; k < 2; ++k) \
        acc[ai][bj][m][n] = __builtin_amdgcn_mfma_f32_16x16x32_bf16(Bt[n][k], At[m][k], acc[ai][bj][m][n], 0, 0, 0); __builtin_amdgcn_s_setprio(0); } while (0)
#define PG8_WAIT_V(n) asm volatile("s_waitcnt vmcnt(" #n ")" ::: "memory")
#define PG8_WAIT_L(n) asm volatile("s_waitcnt lgkmcnt(" #n ")" ::: "memory")
#define PG8_BAR __builtin_amdgcn_s_barrier()
#define PG8_SCHED __builtin_amdgcn_sched_barrier(0)
    Unit cur, nxt; int ui = 0;
    if (!S.next(0, cur)) return;
    f32x4 acc[2][2][4][2];
#pragma unroll
    for (int a = 0; a < 2; ++a)
#pragma unroll
        for (int b = 0; b < 2; ++b)
#pragma unroll
            for (int m = 0; m < 4; ++m)
#pragma unroll
                for (int n = 0; n < 2; ++n) acc[a][b][m][n] = (f32x4){0.f, 0.f, 0.f, 0.f};
    bf16x8 At[4][2], B0[2][2], B1[2][2];
    const char* cA = (const char*)g.A + (size_t)cur.pm * tstep; const char* cB = (const char*)g.Bt + (size_t)cur.pn * tstep;
    S.a_ready(cur);
    if constexpr (SP2) {
        PG8_STAGE(PG8_SB(0, 0), cB, voffB); PG8_STAGE(PG8_SB(0, 1), cB + hstep, voffB); PG8_STAGE(PG8_SA(0, 0), cA, voffA); PG8_STAGE(PG8_SA(0, 1), cA + hstep, voffA);
        if (wr == 1) PG8_BAR;
        PG8_WAIT_V(2); PG8_BAR;
        PG8_STAGE(PG8_SB(1, 0), cB + kstep, voffB); PG8_STAGE(PG8_SA(1, 0), cA + kstep, voffA); PG8_STAGE(PG8_SB(1, 1), cB + hstep + kstep, voffB);
        PG8_WAIT_V(6); PG8_BAR;
    } else {
        PG8_STAGE(PG8_SB(0, 0), cB, voffB); PG8_STAGE(PG8_SA(0, 0), cA, voffA); PG8_STAGE(PG8_SB(0, 1), cB + hstep, voffB); PG8_STAGE(PG8_SA(0, 1), cA + hstep, voffA);
        if (wr == 1) PG8_BAR;
        PG8_WAIT_V(4); PG8_BAR;
        PG8_STAGE(PG8_SB(1, 0), cB + kstep, voffB); PG8_STAGE(PG8_SA(1, 0), cA + kstep, voffA); PG8_STAGE(PG8_SB(1, 1), cB + hstep + kstep, voffB);
        PG8_WAIT_V(6); PG8_BAR;
    }
    for (;;) {
        const bool has_next = S.next(ui + 1, nxt);
        const char* nA = has_next ? (const char*)g.A + (size_t)nxt.pm * tstep : cA; const char* nB = has_next ? (const char*)g.Bt + (size_t)nxt.pn * tstep : cB;
        for (int t = 0; t < nt; t += 2) {
            const bool last = (t == nt - 2);
            const char* a1 = cA + (size_t)(t + 1) * kstep;
            const char* a2 = last ? nA : cA + (size_t)(t + 2) * kstep; const char* b2 = last ? nB : cB + (size_t)(t + 2) * kstep;
            const char* a3 = a2 + kstep; const char* b3 = b2 + kstep;
            if (last && has_next) S.a_ready(nxt);
            if constexpr (SP2) {
            PG8_LDB(B0, 0, 0); PG8_LDB(B1, 0, 1); PG8_SCHED; PG8_LDA(At, 0, 0); PG8_STAGE(PG8_SA(1, 1), a1 + hstep, voffA);
            PG8_WAIT_V(8); PG8_WAIT_L(0); PG8_BAR; PG8_MMA(0, 0, At, B0); PG8_MMA(0, 1, At, B1); PG8_BAR; PG8_SCHED;
            PG8_LDA(At, 0, 1); PG8_STAGE(PG8_SB(0, 0), b2, voffB); PG8_STAGE(PG8_SB(0, 1), b2 + hstep, voffB); PG8_STAGE(PG8_SA(0, 0), a2, voffA);
            PG8_WAIT_V(8); PG8_WAIT_L(0); PG8_BAR; PG8_MMA(1, 0, At, B0); PG8_MMA(1, 1, At, B1); PG8_BAR; PG8_SCHED;
            PG8_LDB(B0, 1, 0); PG8_LDB(B1, 1, 1); PG8_SCHED; PG8_LDA(At, 1, 0); PG8_STAGE(PG8_SA(0, 1), a2 + hstep, voffA);
            PG8_WAIT_V(8); PG8_WAIT_L(0); PG8_BAR; PG8_MMA(0, 0, At, B0); PG8_MMA(0, 1, At, B1); PG8_BAR; PG8_SCHED;
            PG8_LDA(At, 1, 1); PG8_STAGE(PG8_SB(1, 0), b3, voffB); PG8_STAGE(PG8_SB(1, 1), b3 + hstep, voffB); PG8_STAGE(PG8_SA(1, 0), a3, voffA);
            PG8_WAIT_V(8); PG8_WAIT_L(0); PG8_BAR; PG8_MMA(1, 0, At, B0); PG8_MMA(1, 1, At, B1); PG8_BAR; PG8_SCHED;
            } else {
            PG8_LDB(B0, 0, 0); PG8_SCHED; PG8_LDA(At, 0, 0); PG8_STAGE(PG8_SA(1, 1), a1 + hstep, voffA);
            PG8_WAIT_L(8); PG8_BAR; PG8_WAIT_L(0); PG8_MMA(0, 0, At, B0); PG8_BAR; PG8_SCHED;
            PG8_LDB(B1, 0, 1); PG8_STAGE(PG8_SB(0, 0), b2, voffB);
            PG8_BAR; PG8_WAIT_L(0); PG8_MMA(0, 1, At, B1); PG8_BAR;
            PG8_LDA(At, 0, 1); PG8_STAGE(PG8_SA(0, 0), a2, voffA);
            PG8_BAR; PG8_WAIT_L(0); PG8_MMA(1, 0, At, B0); PG8_BAR; PG8_SCHED;
            PG8_STAGE(PG8_SB(0, 1), b2 + hstep, voffB);
            PG8_WAIT_V(6); PG8_BAR; PG8_MMA(1, 1, At, B1); PG8_BAR;
            PG8_LDB(B0, 1, 0); PG8_SCHED; PG8_LDA(At, 1, 0); PG8_STAGE(PG8_SA(0, 1), a2 + hstep, voffA);
            PG8_WAIT_L(8); PG8_BAR; PG8_WAIT_L(0); PG8_MMA(0, 0, At, B0); PG8_BAR; PG8_SCHED;
            PG8_LDB(B1, 1, 1); PG8_STAGE(PG8_SB(1, 0), b3, voffB);
            PG8_BAR; PG8_WAIT_L(0); PG8_MMA(0, 1, At, B1); PG8_BAR;
            PG8_LDA(At, 1, 1); PG8_STAGE(PG8_SA(1, 0), a3, voffA);
            PG8_BAR; PG8_WAIT_L(0); PG8_MMA(1, 0, At, B0); PG8_BAR; PG8_SCHED;
            PG8_STAGE(PG8_SB(1, 1), b3 + hstep, voffB);
            PG8_WAIT_V(6); PG8_BAR; PG8_MMA(1, 1, At, B1); PG8_BAR;
            }
        }
        if constexpr (ALIGN_EPI) { if (wr == 0) PG8_BAR; }
        E(acc, cur, wr, wc, fr, fq, misc, tid); S.done(cur);
        if (!has_next) break;
#pragma unroll
        for (int a = 0; a < 2; ++a)
#pragma unroll
            for (int b = 0; b < 2; ++b)
#pragma unroll
                for (int m = 0; m < 4; ++m)
#pragma unroll
                    for (int n = 0; n < 2; ++n) acc[a][b][m][n] = (f32x4){0.f, 0.f, 0.f, 0.f};
        cur = nxt; cA = nA; cB = nB; ++ui;
        if constexpr (ALIGN_EPI) { if (wr == 1) PG8_BAR; }
    }
    PG8_WAIT_V(0);
    if constexpr (!ALIGN_EPI) { if (wr == 0) PG8_BAR; }
    PG8_BAR;
#undef PG8_SA
#undef PG8_SB
#undef PG8_STAGE
#undef PG8_LDA
#undef PG8_LDB
#undef PG8_MMA
#undef PG8_WAIT_V
#undef PG8_WAIT_L
#undef PG8_BAR
#undef PG8_SCHED
}
}

#define XB_TMO      128
#define XB_XCNT(j)  (256  + 64 * (j))
#define XB_XSUB(j)  (1280 + 64 * (j))
#define XB_XGEN(j)  (2304 + 64 * (j))
#define XB_TOP      3328
#define XB_TOPGEN   3392
#define XCD_BAR_WORDS 3456
#define XB_SPIN_CAP (1u << 18)

DI unsigned xb_ld(unsigned* p)              { return __hip_atomic_load(p, __ATOMIC_RELAXED, __HIP_MEMORY_SCOPE_AGENT); }
DI unsigned xb_add(unsigned* p, unsigned v) { return __hip_atomic_fetch_add(p, v, __ATOMIC_RELAXED, __HIP_MEMORY_SCOPE_AGENT); }
DI unsigned xb_xcc_id() { return (unsigned)__builtin_amdgcn_s_getreg((3 << 11) | 20) & 0xFu; }
#define XB_SPIN(cond, bar) do { unsigned _sp = 0; while (cond) { __builtin_amdgcn_s_sleep(1); \
    if ((++_sp & 255u) == 0u) { if (xb_ld(&(bar)[XB_TMO])) break; if (_sp > XB_SPIN_CAP) { atomicAdd(&(bar)[XB_TMO], 1u); break; } } } } while (0)

struct XcdBarrier { unsigned* bar; unsigned x; volatile LAS unsigned* st; };

DI XcdBarrier xcd_barrier_post(unsigned* bar, volatile LAS unsigned* st) {
    XcdBarrier b; b.bar = bar; b.x = xb_xcc_id(); b.st = st;
    if (threadIdx.x == 0) (void)xb_add(&bar[XB_XCNT(b.x)], 1u);
    return b;
}
DI void xcd_barrier_complete(unsigned* bar, unsigned x, unsigned& nloc, unsigned& nx) {
    const unsigned G = gridDim.x * gridDim.y * gridDim.z;
    unsigned sum, cnt, mine, sp = 0u;
    for (;;) {
        sum = 0u; cnt = 0u; mine = 0u;
#pragma unroll
        for (unsigned j = 0; j < 16; ++j) { const unsigned c = xb_ld(&bar[XB_XCNT(j)]); sum += c; cnt += (c > 0u) ? 1u : 0u; mine = (j == x) ? c : mine; }
        if (sum == G) break;
        __builtin_amdgcn_s_sleep(1);
        if ((++sp & 255u) == 0u) { if (xb_ld(&bar[XB_TMO])) break; if (sp > XB_SPIN_CAP) { atomicAdd(&bar[XB_TMO], 1u); break; } }
    }
    nloc = mine > 0u ? mine : 1u; nx = cnt > 0u ? cnt : 1u;
}
DI void xcd_barrier(const XcdBarrier& b) {
    asm volatile("s_waitcnt vmcnt(0)" ::: "memory");
    __syncthreads();
    if (threadIdx.x == 0) {
        unsigned* bar = b.bar;
        __builtin_amdgcn_s_waitcnt(0);
        unsigned nloc = b.st[0], nx = b.st[1];
        if (nloc == 0u) { xcd_barrier_complete(bar, b.x, nloc, nx); b.st[0] = nloc; b.st[1] = nx; }
        const unsigned old = xb_add(&bar[XB_XSUB(b.x)], 1u);
        const unsigned gen = old / nloc;
        if (old + 1u == (gen + 1u) * nloc) {
            __builtin_amdgcn_fence(__ATOMIC_RELEASE, "agent");
            asm volatile("s_waitcnt vmcnt(0)" ::: "memory");
            const unsigned og = xb_add(&bar[XB_TOP], 1u);
            const unsigned tg = og / nx;
            if (og + 1u == (tg + 1u) * nx) xb_add(&bar[XB_TOPGEN], 1u);
            else XB_SPIN(xb_ld(&bar[XB_TOPGEN]) == tg, bar);
            __builtin_amdgcn_fence(__ATOMIC_ACQUIRE, "agent");
            xb_add(&bar[XB_XGEN(b.x)], 1u);
            asm volatile("s_waitcnt vmcnt(0)" ::: "memory");
        } else {
            XB_SPIN(xb_ld(&bar[XB_XGEN(b.x)]) == gen, bar);
            __builtin_amdgcn_fence(__ATOMIC_ACQUIRE, "agent");
            asm volatile("s_waitcnt vmcnt(0)" ::: "memory");
        }
    }
    __syncthreads();
}

struct Args {
    const float* in[19]; float* out; unsigned char* ws; int ph_lo, ph_hi, li, pad;
};
struct Frame {
    LAS unsigned char* lds; LAS unsigned char* misc;
    int G, bid;
    const float *xp, *xs, *st_pool, *st_conv, *st_ret, *norm1_g, *w_in, *pool_w, *pool_scale, *conv_w, *ret_norm_g, *sgu_norm_g, *sgu_w, *sgu_b, *w_out, *norm2_g, *w_gu, *w_dn, *final_g;
    float* out;
    float *ROPE, *SSQ1, *SSQ2, *H, *KV;
    bf16_t *POOLW, *SGUW, *WIN, *WOUT, *WGU, *WDN, *HB, *PB, *MIX, *ACT;
};

DI unsigned off_b(unsigned row, unsigned ch) { return 256u * row + 16u * (ch ^ (((row & 3u) << 2) | ((row >> 2) & 3u))); }
DI bf16x8 lds_rowfrag(const LAS unsigned char* tile, int lane, int rb, int s) { return *(const LAS bf16x8*)(tile + off_b((unsigned)((lane & 15) + 16 * rb), (unsigned)(4 * s + (lane >> 4)))); }
DI bf16x8 lds_trfrag(const LAS unsigned char* tile, int lane, int c, int ks) {
    const unsigned g = lane >> 4, q = (lane & 15) >> 2, p = lane & 3;
    const unsigned a0 = off_b(32u * ks + 8u * g + q, 2u * c + (p >> 1)) + 8u * (p & 1);
    const unsigned a1 = off_b(32u * ks + 8u * g + 4u + q, 2u * c + (p >> 1)) + 8u * (p & 1);
    const s16x4 lo = __builtin_amdgcn_ds_read_tr16_b64_v4i16((LAS s16x4*)(tile + a0));
    const s16x4 hi = __builtin_amdgcn_ds_read_tr16_b64_v4i16((LAS s16x4*)(tile + a1));
    return __builtin_shufflevector(lo, hi, 0, 1, 2, 3, 4, 5, 6, 7);
}
#define MFMA16(a, b, c) __builtin_amdgcn_mfma_f32_16x16x32_bf16((a), (b), (c), 0, 0, 0)

constexpr float LG2_GAMMA[4] = {-0.04580368961312479f, -0.02272007650008353f, -0.011315313227834146f, -0.005646563141142063f};
DI float lg2_gamma(int h) { return h == 0 ? LG2_GAMMA[0] : h == 1 ? LG2_GAMMA[1] : h == 2 ? LG2_GAMMA[2] : LG2_GAMMA[3]; }

constexpr int EPS_STRIDE = 132;
DI void epi_scatter(LAS float* scr, const f32x4 (&acc)[8], int lane) {
#pragma unroll
    for (int c = 0; c < 8; ++c)
#pragma unroll
        for (int r = 0; r < 4; ++r) scr[(4 * (lane >> 4) + r) * EPS_STRIDE + 16 * c + (lane & 15)] = acc[c][r];
}
DI void epi_gather(const LAS float* scr, int lane, int p, float (&v)[8]) {
    const LAS float* s = scr + (4 * p + (lane >> 4)) * EPS_STRIDE + 8 * (lane & 15);
    const f32x4 a = *(const LAS f32x4*)s, b = *(const LAS f32x4*)(s + 4);
    v[0] = a[0]; v[1] = a[1]; v[2] = a[2]; v[3] = a[3]; v[4] = b[0]; v[5] = b[1]; v[6] = b[2]; v[7] = b[3];
}
DI void unpack8(const u32x4 w, float (&x)[8]) { x[0] = bflo(w.x); x[1] = bfhi(w.x); x[2] = bflo(w.y); x[3] = bfhi(w.y); x[4] = bflo(w.z); x[5] = bfhi(w.z); x[6] = bflo(w.w); x[7] = bfhi(w.w); }
DI u32x4 pack8(const float (&x)[8]) { u32x4 w; w.x = pk2(x[0], x[1]); w.y = pk2(x[2], x[3]); w.z = pk2(x[4], x[5]); w.w = pk2(x[6], x[7]); return w; }

template <bool GUMAP>
DI void p0_transpose_item(const float* W, int K, int N, bf16_t* WT, const float* gk, LAS float* scr, int item, int lane) {
    const int nblk = N / 32, kb = item / nblk, nb = item % nblk, k0 = 64 * kb, n0 = 32 * nb;
#pragma unroll 8
    for (int i = 0; i < 32; ++i) { const int kk = 2 * i + (lane >> 5); float v = W[(size_t)(k0 + kk) * N + n0 + (lane & 31)]; if (gk) v *= gk[k0 + kk]; scr[kk * 33 + (lane & 31)] = v; }
    asm volatile("s_waitcnt lgkmcnt(0)" ::: "memory");
    int d0 = n0;
    if (GUMAP) { d0 = (n0 < FF) ? ((n0 >> 7) * 256 + (n0 & 127)) : (((n0 - FF) >> 7) * 256 + 128 + ((n0 - FF) & 127)); }
    const int c = lane & 7;
#pragma unroll
    for (int j = 0; j < 4; ++j) { const int n = (lane >> 3) + 8 * j; const LAS float* s = scr + (8 * c) * 33 + n;
        u32x4 o; o.x = pk2(s[0 * 33], s[1 * 33]); o.y = pk2(s[2 * 33], s[3 * 33]); o.z = pk2(s[4 * 33], s[5 * 33]); o.w = pk2(s[6 * 33], s[7 * 33]);
        *(u32x4*)(WT + (size_t)(d0 + n) * K + k0 + 8 * c) = o; }
    asm volatile("s_waitcnt lgkmcnt(0)" ::: "memory");
}
DI void p0_prologue(Frame& F) {
    const int tid = opaque_tid(), lane = tid & 63, wave = __builtin_amdgcn_readfirstlane(tid >> 6);
    LAS float* scr = (LAS float*)(F.lds + wave * 16384);
    const int gw = F.bid * 8 + wave, NGW = F.G * 8;
    constexpr int I_IN = (D / 64) * (INW / 32), I_OUT = (D / 64) * (D / 32), I_GU = (D / 64) * (GU / 32), I_DN = (FF / 64) * (D / 32);
    constexpr int I_L = I_IN + I_OUT + I_GU + I_DN, NITEMS = DEPTH * I_L;
    for (int it = gw; it < NITEMS; it += NGW) {
        const int l = it / I_L; int r = it % I_L;
        if (r < I_IN) { p0_transpose_item<false>(F.w_in + (size_t)l * D * INW, D, INW, F.WIN + (size_t)l * INW * D, F.norm1_g + l * D, scr, r, lane); continue; } r -= I_IN;
        if (r < I_OUT) { p0_transpose_item<false>(F.w_out + (size_t)l * D * D, D, D, F.WOUT + (size_t)l * D * D, nullptr, scr, r, lane); continue; } r -= I_OUT;
        if (r < I_GU) { p0_transpose_item<true>(F.w_gu + (size_t)l * D * GU, D, GU, F.WGU + (size_t)l * GU * D, F.norm2_g + l * D, scr, r, lane); continue; } r -= I_GU;
        p0_transpose_item<false>(F.w_dn + (size_t)l * FF * D, FF, D, F.WDN + (size_t)l * D * FF, nullptr, scr, r, lane);
    }
    for (int m = gw; m < MV; m += NGW) {
        const float* xrow = (m < MPR) ? F.xp + (size_t)m * D : F.xs + (size_t)(m - MPR) * D;
        const f32x4* xr = (const f32x4*)xrow + lane; float ss = 0.f; u32x2* o8 = (u32x2*)(F.HB + (size_t)m * D) + lane;
#pragma unroll
        for (int j = 0; j < 8; ++j) { const f32x4 v = xr[64 * j]; ss += (v[0] * v[0] + v[1] * v[1]) + (v[2] * v[2] + v[3] * v[3]); u32x2 w; w.x = pk2(v[0], v[1]); w.y = pk2(v[2], v[3]); o8[64 * j] = w; }
        ss = wave_sum(ss);
        if (lane < 8) F.SSQ1[(size_t)m * 8 + lane] = (lane == 0) ? ss : 0.f;
    }
    const int gt = F.bid * 512 + tid, NGT = F.G * 512;
    for (int i = gt; i < 2049 * 64; i += NGT) { const int pi = i >> 6, f = i & 63; const float pos = (pi < 2048) ? (float)pi : 16384.0f;
        double pw = 1.0, bs = 0.8659643233600653523531691834202299819398;
#pragma unroll
        for (int bit = 0; bit < 6; ++bit) { if ((f >> bit) & 1) pw *= bs; bs *= bs; }
        const float inv = (float)pw; const float ang = pos * inv;
        const double a = (double)ang, kq = __builtin_rint(a * 0.63661977236758134308);
        double r = __builtin_fma(-kq, 1.57079632679489655800e+00, a); r = __builtin_fma(-kq, 6.12323399573676603587e-17, r);
        const double r2 = r * r;
        const double sp = r * (1.0 + r2 * (-1.0 / 6.0 + r2 * (1.0 / 120.0 + r2 * (-1.0 / 5040.0 + r2 * (1.0 / 362880.0 + r2 * (-1.0 / 39916800.0 + r2 * (1.0 / 6227020800.0 + r2 * (-1.0 / 1307674368000.0))))))));
        const double cp = 1.0 + r2 * (-0.5 + r2 * (1.0 / 24.0 + r2 * (-1.0 / 720.0 + r2 * (1.0 / 40320.0 + r2 * (-1.0 / 3628800.0 + r2 * (1.0 / 479001600.0 + r2 * (-1.0 / 87178291200.0 + r2 * (1.0 / 20922789888000.0))))))));
        const int q = (int)((long long)kq & 3);
        const double sn = (q == 0) ? sp : (q == 1) ? cp : (q == 2) ? -sp : -cp, cs = (q == 0) ? cp : (q == 1) ? -sp : (q == 2) ? -cp : sp;
        F.ROPE[2 * i] = (float)cs; F.ROPE[2 * i + 1] = (float)sn; }
    for (int i = gt; i < DEPTH * 4 * 128 * 128; i += NGT) { const int e = i & 127, g4 = (i >> 14) & 3, l = i >> 16;
        F.POOLW[i] = (bf16_t)(pk2(F.pool_w[i] * F.pool_scale[l * 512 + g4 * 128 + e], 0.f) & 0xffffu);
        const int s = i & 127, t = (i >> 7) & 127; F.SGUW[i] = (bf16_t)(pk2(t >= s ? F.sgu_w[i] : 0.f, 0.f) & 0xffffu); }
}

template <class RowMul>
DI void stage_rot(LAS unsigned char* tile, const bf16_t* src, const float* rope_pos0, int tid, RowMul rowmul) {
#pragma unroll
    for (int it = 0; it < 2; ++it) { const int task = tid + 512 * it, row = task >> 3, cp = task & 7;
        const u32x4 lo = *(const u32x4*)(src + (size_t)row * INW + 8 * cp), hi = *(const u32x4*)(src + (size_t)row * INW + 64 + 8 * cp);
        const f32x4* rp = (const f32x4*)(rope_pos0 + (size_t)row * 128 + 16 * cp);
        const f32x4 r0 = rp[0], r1 = rp[1], r2 = rp[2], r3 = rp[3];
        const float cs[8] = {r0[0], r0[2], r1[0], r1[2], r2[0], r2[2], r3[0], r3[2]}, sn[8] = {r0[1], r0[3], r1[1], r1[3], r2[1], r2[3], r3[1], r3[3]};
        float x1[8], x2[8], o1[8], o2[8]; unpack8(lo, x1); unpack8(hi, x2); const float sc = rowmul(row);
#pragma unroll
        for (int i = 0; i < 8; ++i) { o1[i] = (x1[i] * cs[i] - x2[i] * sn[i]) * sc; o2[i] = (x2[i] * cs[i] + x1[i] * sn[i]) * sc; }
        *(LAS u32x4*)(tile + off_b(row, cp)) = pack8(o1); *(LAS u32x4*)(tile + off_b(row, cp + 8)) = pack8(o2); }
}
DI void stage_copy(LAS unsigned char* tile, const bf16_t* src, int pitch, int tid) {
#pragma unroll
    for (int it = 0; it < 4; ++it) { const int task = tid + 512 * it, row = task >> 4, ch = task & 15;
        *(LAS u32x4*)(tile + off_b(row, ch)) = *(const u32x4*)(src + (size_t)row * pitch + 8 * ch); }
}

DI void ret_kv_unit(Frame& F, int b, int h, int n) {
    LAS unsigned char* TK = F.lds; LAS unsigned char* TV = F.lds + 32768;
    const int tid = opaque_tid(), lane = tid & 63, w = __builtin_amdgcn_readfirstlane(tid >> 6); const float lg = lg2_gamma(h);
    __syncthreads();
    const size_t row0 = (size_t)b * SEQ + (size_t)n * 128;
    stage_rot(TK, F.PB + row0 * INW + C_K + h * 128, F.ROPE + (size_t)(n * 128) * 128, tid, [lg](int row) { return 0.08838834764831845f * exp2f((float)(127 - row) * lg); });
    stage_copy(TV, F.PB + row0 * INW + C_V + h * 128, INW, tid);
    __syncthreads();
    f32x4 acc[8];
#pragma unroll
    for (int c = 0; c < 8; ++c) acc[c] = (f32x4){0.f, 0.f, 0.f, 0.f};
#pragma unroll
    for (int ks = 0; ks < 4; ++ks) { const bf16x8 a = lds_trfrag(TK, lane, w, ks);
#pragma unroll
        for (int c = 0; c < 8; ++c) { const bf16x8 bb = lds_trfrag(TV, lane, c, ks); acc[c] = MFMA16(a, bb, acc[c]); } }
    float* kv = F.KV + ((size_t)((b * 4 + h) * NCH + n)) * 16384;
#pragma unroll
    for (int c = 0; c < 8; ++c)
#pragma unroll
        for (int r = 0; r < 4; ++r) kv[(16 * w + 4 * (lane >> 4) + r) * 128 + 16 * c + (lane & 15)] = acc[c][r];
}

DI void ret_out_unit(Frame& F, int l, int b, int h, int n) {
    LAS unsigned char* TQ = F.lds; LAS unsigned char* TK = F.lds + 32768; LAS unsigned char* TV = F.lds + 65536; LAS unsigned char* TS = F.lds + 98304;
    const int tid = opaque_tid(), lane = tid & 63, w = __builtin_amdgcn_readfirstlane(tid >> 6); const float lg = lg2_gamma(h);
    __syncthreads();
    const size_t row0 = (size_t)b * SEQ + (size_t)n * 128;
    const float* rope0 = F.ROPE + (size_t)(n * 128) * 128;
    stage_rot(TQ, F.PB + row0 * INW + C_Q + h * 128, rope0, tid, [](int) { return 1.0f; });
    stage_rot(TK, F.PB + row0 * INW + C_K + h * 128, rope0, tid, [](int) { return 0.08838834764831845f; });
    stage_copy(TV, F.PB + row0 * INW + C_V + h * 128, INW, tid);
    if (n > 0) {
        const float* kvb = F.KV + ((size_t)((b * 4 + h) * NCH)) * 16384;
        f32x4 s[4][2];
#pragma unroll
        for (int it = 0; it < 4; ++it) { s[it][0] = (f32x4){0.f, 0.f, 0.f, 0.f}; s[it][1] = (f32x4){0.f, 0.f, 0.f, 0.f}; }
        for (int m = 0; m < n; ++m) { const float cf = exp2f((float)(128 * (n - 1 - m)) * lg); const float* kv = kvb + (size_t)m * 16384;
#pragma unroll
            for (int it = 0; it < 4; ++it) { const int task = tid + 512 * it; const f32x4* p = (const f32x4*)(kv + task * 8); s[it][0] += p[0] * cf; s[it][1] += p[1] * cf; } }
#pragma unroll
        for (int it = 0; it < 4; ++it) { const int task = tid + 512 * it, row = task >> 4, ch = task & 15;
            u32x4 o; o.x = pk2(s[it][0][0], s[it][0][1]); o.y = pk2(s[it][0][2], s[it][0][3]); o.z = pk2(s[it][1][0], s[it][1][1]); o.w = pk2(s[it][1][2], s[it][1][3]);
            *(LAS u32x4*)(TS + off_b(row, ch)) = o; }
    }
    __syncthreads();
    f32x4 acc[8];
#pragma unroll
    for (int c = 0; c < 8; ++c) acc[c] = (f32x4){0.f, 0.f, 0.f, 0.f};
    bf16x8 qf[4];
#pragma unroll
    for (int s = 0; s < 4; ++s) qf[s] = lds_rowfrag(TQ, lane, w, s);
    if (n > 0) {
#pragma unroll
        for (int s = 0; s < 4; ++s)
#pragma unroll
            for (int c = 0; c < 8; ++c) { const bf16x8 bb = lds_trfrag(TS, lane, c, s); acc[c] = MFMA16(qf[s], bb, acc[c]); }
        float f[4];
#pragma unroll
        for (int r = 0; r < 4; ++r) f[r] = exp2f((float)(16 * w + 4 * (lane >> 4) + r + 1) * lg);
#pragma unroll
        for (int c = 0; c < 8; ++c)
#pragma unroll
            for (int r = 0; r < 4; ++r) acc[c][r] *= f[r];
    }
    const int i_loc = 16 * w + (lane & 15);
#pragma unroll
    for (int c = 0; c < 8; ++c) if (c <= w) {
        f32x4 sc = (f32x4){0.f, 0.f, 0.f, 0.f};
#pragma unroll
        for (int s = 0; s < 4; ++s) { const bf16x8 kf = lds_rowfrag(TK, lane, c, s); sc = MFMA16(kf, qf[s], sc); }
        float pv[4];
#pragma unroll
        for (int r = 0; r < 4; ++r) { const int j = 16 * c + 4 * (lane >> 4) + r; const int dd = i_loc - j; pv[r] = dd >= 0 ? sc[r] * exp2f((float)dd * lg) : 0.f; }
        u32x2 o; o.x = pk2(pv[0], pv[1]); o.y = pk2(pv[2], pv[3]);
        *(LAS u32x2*)(TQ + off_b(i_loc, 2 * c + (lane >> 5)) + 8 * ((lane >> 4) & 1)) = o;
    }
    if ((w & 1) == 0) { unsigned zz = 0u; asm volatile("" : "+v"(zz)); u32x2 z; z.x = zz; z.y = zz; *(LAS u32x2*)(TQ + off_b(i_loc, 2 * (w + 1) + (lane >> 5)) + 8 * ((lane >> 4) & 1)) = z; }
#pragma unroll
    for (int ks = 0; ks < 4; ++ks) if (ks <= (w >> 1)) { const bf16x8 a = lds_rowfrag(TQ, lane, w, ks);
#pragma unroll
        for (int c = 0; c < 8; ++c) { const bf16x8 bb = lds_trfrag(TV, lane, c, ks); acc[c] = MFMA16(a, bb, acc[c]); } }
#pragma unroll
    for (int r = 0; r < 4; ++r) { float s = 0.f;
#pragma unroll
        for (int c = 0; c < 8; ++c) s += acc[c][r];
        s += __shfl_xor(s, 1); s += __shfl_xor(s, 2); s += __shfl_xor(s, 4); s += __shfl_xor(s, 8);
        const float mean = s * (1.0f / 128.0f); float q = 0.f;
#pragma unroll
        for (int c = 0; c < 8; ++c) { const float d = acc[c][r] - mean; acc[c][r] = d; q += d * d; }
        q += __shfl_xor(q, 1); q += __shfl_xor(q, 2); q += __shfl_xor(q, 4); q += __shfl_xor(q, 8);
        const float rstd = 1.0f / sqrtf(q * (1.0f / 128.0f) + NORM_EPS);
#pragma unroll
        for (int c = 0; c < 8; ++c) acc[c][r] *= rstd; }
    __syncthreads();
    LAS float* scr = (LAS float*)(F.lds + w * 8448);
    epi_scatter(scr, acc, lane);
    const float* gn = F.ret_norm_g + l * 512 + h * 128 + 8 * (lane & 15);
    const f32x4 g0 = *(const f32x4*)gn, g1 = *(const f32x4*)(gn + 4);
    const float gg[8] = {g0[0], g0[1], g0[2], g0[3], g1[0], g1[1], g1[2], g1[3]};
#pragma unroll
    for (int p = 0; p < 4; ++p) { float v[8]; epi_gather(scr, lane, p, v); const size_t grow = row0 + 16 * w + 4 * p + (lane >> 4);
        float gt[8]; unpack8(*(const u32x4*)(F.PB + grow * INW + C_G + h * 128 + 8 * (lane & 15)), gt);
#pragma unroll
        for (int i = 0; i < 8; ++i) v[i] = v[i] * gg[i] * silu_f(gt[i]);
        *(u32x4*)(F.MIX + grow * D + 1024 + h * 128 + 8 * (lane & 15)) = pack8(v); }
}

DI void pool_unit(Frame& F, int l, int b, int tt, int gi) {
    LAS unsigned char* TA = F.lds; LAS unsigned char* TD = F.lds + 40960; LAS unsigned char* TW = F.lds + 73728;
    const int tid = opaque_tid(), lane = tid & 63, w = __builtin_amdgcn_readfirstlane(tid >> 6);
    __syncthreads();
    for (int task = tid; task < 143 * 16; task += 512) { const int r = task >> 4, ch = task & 15, tseq = tt * 128 - 15 + r;
        u32x4 v = (u32x4){0u, 0u, 0u, 0u};
        if (tseq >= 0) v = *(const u32x4*)(F.PB + ((size_t)b * SEQ + tseq) * INW + C_A + gi * 128 + 8 * ch);
        *(LAS u32x4*)(TA + r * 256 + ch * 16) = v; }
    stage_copy(TW, F.POOLW + (size_t)((l * 4 + gi) * 128) * 128, 128, tid);
    __syncthreads();
    const int win = 2 << gi;
#pragma unroll
    for (int it = 0; it < 4; ++it) { const int task = tid + 512 * it, t = task >> 4, ch = task & 15;
        float s[8], a[8];
        unpack8(*(const LAS u32x4*)(TA + (t + 15) * 256 + ch * 16), a);
#pragma unroll
        for (int i = 0; i < 8; ++i) s[i] = a[i];
        for (int j = 1; j < win; ++j) { float x[8]; unpack8(*(const LAS u32x4*)(TA + (t + 15 - j) * 256 + ch * 16), x);
#pragma unroll
            for (int i = 0; i < 8; ++i) s[i] += x[i]; }
        const int pos = tt * 128 + t; const float inv = 1.0f / (float)(pos + 1 < win ? pos + 1 : win);
        float d[8];
#pragma unroll
        for (int i = 0; i < 8; ++i) d[i] = s[i] * inv - a[i];
        *(LAS u32x4*)(TD + off_b(t, ch)) = pack8(d);
        if (tt == NCH - 1 && t >= 113) { float* o = F.out + O_POOLP + ((size_t)((l * NB + b) * 15 + (t - 113))) * 512 + gi * 128 + 8 * ch;
            *(f32x4*)o = (f32x4){a[0], a[1], a[2], a[3]}; *(f32x4*)(o + 4) = (f32x4){a[4], a[5], a[6], a[7]}; }
    }
    __syncthreads();
    f32x4 acc[8];
#pragma unroll
    for (int c = 0; c < 8; ++c) acc[c] = (f32x4){0.f, 0.f, 0.f, 0.f};
#pragma unroll
    for (int s = 0; s < 4; ++s) { const bf16x8 a = lds_rowfrag(TD, lane, w, s);
#pragma unroll
        for (int c = 0; c < 8; ++c) { const bf16x8 bb = lds_trfrag(TW, lane, c, s); acc[c] = MFMA16(a, bb, acc[c]); } }
    __syncthreads();
    LAS float* scr = (LAS float*)(F.lds + w * 8448);
    epi_scatter(scr, acc, lane);
#pragma unroll
    for (int p = 0; p < 4; ++p) { float v[8]; epi_gather(scr, lane, p, v); const size_t grow = (size_t)b * SEQ + tt * 128 + 16 * w + 4 * p + (lane >> 4);
        *(u32x4*)(F.MIX + grow * D + gi * 128 + 8 * (lane & 15)) = pack8(v); }
}

DI void sgu_unit(Frame& F, int l, int b, int ck, int h) {
    LAS unsigned char* TV = F.lds;
    const int tid = opaque_tid(), lane = tid & 63, w = __builtin_amdgcn_readfirstlane(tid >> 6);
    __syncthreads();
    const size_t row0 = (size_t)b * SEQ + (size_t)ck * 128;
    { const float* gp = F.sgu_norm_g + l * 512 + 8 * lane; const f32x4 g0 = *(const f32x4*)gp, g1 = *(const f32x4*)(gp + 4);
      const float gg[8] = {g0[0], g0[1], g0[2], g0[3], g1[0], g1[1], g1[2], g1[3]};
      for (int it = 0; it < 16; ++it) { const int st = 16 * w + it;
        float x[8]; unpack8(*(const u32x4*)(F.PB + (row0 + st) * INW + C_VV + 8 * lane), x);
        float s = ((x[0] + x[1]) + (x[2] + x[3])) + ((x[4] + x[5]) + (x[6] + x[7]));
        const float mean = wave_sum(s) * (1.0f / 512.0f); float q = 0.f;
#pragma unroll
        for (int i = 0; i < 8; ++i) { x[i] -= mean; q += x[i] * x[i]; }
        const float rstd = 1.0f / sqrtf(wave_sum(q) * (1.0f / 512.0f) + NORM_EPS);
        if ((lane >> 4) == h) {
#pragma unroll
            for (int i = 0; i < 8; ++i) x[i] = x[i] * rstd * gg[i];
            *(LAS u32x4*)(TV + off_b(st, lane & 15)) = pack8(x);
            if (ck == NCH - 1) { float* o = F.out + O_SGUP + ((size_t)((l * NB + b) * 128 + st)) * 512 + 8 * lane;
                *(f32x4*)o = (f32x4){x[0], x[1], x[2], x[3]}; *(f32x4*)(o + 4) = (f32x4){x[4], x[5], x[6], x[7]}; } } } }
    __syncthreads();
    f32x4 acc[8];
#pragma unroll
    for (int c = 0; c < 8; ++c) acc[c] = (f32x4){0.f, 0.f, 0.f, 0.f};
    const bf16_t* wrow = F.SGUW + ((size_t)((l * 4 + h) * 128 + 16 * w + (lane & 15))) * 128 + 8 * (lane >> 4);
#pragma unroll
    for (int ks = 0; ks < 4; ++ks) if (ks <= (w >> 1)) { const bf16x8 a = *(const bf16x8*)(wrow + 32 * ks);
#pragma unroll
        for (int c = 0; c < 8; ++c) { const bf16x8 bb = lds_trfrag(TV, lane, c, ks); acc[c] = MFMA16(a, bb, acc[c]); } }
    __syncthreads();
    LAS float* scr = (LAS float*)(F.lds + w * 8448);
    epi_scatter(scr, acc, lane);
#pragma unroll
    for (int p = 0; p < 4; ++p) { float v[8]; epi_gather(scr, lane, p, v); const int t = 16 * w + 4 * p + (lane >> 4); const size_t grow = row0 + t;
        const float bias = F.sgu_b[(l * 4 + h) * 128 + t];
        float u[8]; unpack8(*(const u32x4*)(F.PB + grow * INW + C_U + h * 128 + 8 * (lane & 15)), u);
#pragma unroll
        for (int i = 0; i < 8; ++i) v[i] = u[i] * (v[i] + bias);
        *(u32x4*)(F.MIX + grow * D + 1536 + h * 128 + 8 * (lane & 15)) = pack8(v); }
}

DI void conv_flat(Frame& F, int l) {
    const float* cw = F.conv_w + l * 3 * 512; const int tid = opaque_tid();
    for (int task = F.bid * 512 + tid; task < MPR * 64; task += F.G * 512) { const int row = task >> 6, ch = task & 63, t = row & (SEQ - 1), b = row >> 11;
        const bf16_t* p = F.PB + (size_t)row * INW + 8 * ch;
        float z[3][8];
#pragma unroll
        for (int k = 0; k < 3; ++k) { const int back = 2 - k;
            if (t - back >= 0) { float cg[8], hh[8]; unpack8(*(const u32x4*)(p - (size_t)back * INW + C_CG), cg); unpack8(*(const u32x4*)(p - (size_t)back * INW + C_HH), hh);
#pragma unroll
                for (int i = 0; i < 8; ++i) z[k][i] = cg[i] * hh[i]; }
            else {
#pragma unroll
                for (int i = 0; i < 8; ++i) z[k][i] = 0.f; } }
        float bg[8], y[8]; unpack8(*(const u32x4*)(p + C_BG), bg);
#pragma unroll
        for (int i = 0; i < 8; ++i) { const int c = 8 * ch + i; y[i] = bg[i] * (z[0][i] * cw[c] + z[1][i] * cw[512 + c] + z[2][i] * cw[1024 + c]); }
        *(u32x4*)(F.MIX + (size_t)row * D + 512 + 8 * ch) = pack8(y);
        if (t >= SEQ - 2) { float* o = F.out + O_CONVP + ((size_t)((l * NB + b) * 2 + (t - (SEQ - 2)))) * 512 + 8 * ch;
            *(f32x4*)o = (f32x4){z[2][0], z[2][1], z[2][2], z[2][3]}; *(f32x4*)(o + 4) = (f32x4){z[2][4], z[2][5], z[2][6], z[2][7]}; }
    }
}

DI void ret_final_flat(Frame& F, int l) {
    const int tid = opaque_tid();
    for (int task = F.bid * 512 + tid; task < 16 * 4096; task += F.G * 512) { const int bh = task >> 12, e4 = task & 4095, h = bh & 3; const float lg = lg2_gamma(h);
        const float* kvb = F.KV + (size_t)bh * NCH * 16384 + 4 * e4; f32x4 s = (f32x4){0.f, 0.f, 0.f, 0.f};
#pragma unroll 4
        for (int m = 0; m < NCH; ++m) s += *(const f32x4*)(kvb + (size_t)m * 16384) * exp2f((float)(128 * (NCH - 1 - m)) * lg);
        *(f32x4*)(F.out + O_RETP + ((size_t)(l * 16 + bh)) * 16384 + 4 * e4) = s; }
}

DI void sret_unit(Frame& F, int l, int s, int h) {
    LAS float* qf = (LAS float*)F.lds; LAS float* kf = qf + 128; LAS float* vf = qf + 256; LAS float* red = qf + 384;
    const int tid = opaque_tid(), lane = tid & 63; const size_t row = (size_t)MPR + s; const float gam = exp2f(lg2_gamma(h));
    __syncthreads();
    if (tid < 64) { const bf16_t* p = F.PB + row * INW + h * 128; const float* rp = F.ROPE + ((size_t)ROPE_SPOS * 64 + tid) * 2; const float cs = rp[0], sn = rp[1];
        const float q1 = bf2f(p[C_Q + tid]), q2 = bf2f(p[C_Q + 64 + tid]), k1 = bf2f(p[C_K + tid]), k2 = bf2f(p[C_K + 64 + tid]);
        qf[tid] = q1 * cs - q2 * sn; qf[tid + 64] = q2 * cs + q1 * sn;
        kf[tid] = (k1 * cs - k2 * sn) * 0.08838834764831845f; kf[tid + 64] = (k2 * cs + k1 * sn) * 0.08838834764831845f;
        vf[tid] = bf2f(p[C_V + tid]); vf[tid + 64] = bf2f(p[C_V + 64 + tid]); }
    __syncthreads();
    const int dg = tid >> 5, e4 = (tid & 31) * 4;
    const size_t sb = ((size_t)((l * NS + s) * 4 + h)) * 16384;
    const float* s0 = F.st_ret + sb; float* so = F.out + O_RETS + sb;
    const f32x4 vv = *(const LAS f32x4*)(vf + e4); f32x4 o = (f32x4){0.f, 0.f, 0.f, 0.f};
#pragma unroll
    for (int it = 0; it < 8; ++it) { const int d = dg + 16 * it; const f32x4 a = *(const f32x4*)(s0 + d * 128 + e4); const f32x4 sn = a * gam + vv * kf[d];
        *(f32x4*)(so + d * 128 + e4) = sn; o += sn * qf[d]; }
    *(LAS f32x4*)(red + dg * 128 + e4) = o;
    __syncthreads();
    if (tid < 64) { float o0 = 0.f, o1 = 0.f;
#pragma unroll
        for (int g = 0; g < 16; ++g) { o0 += red[g * 128 + lane]; o1 += red[g * 128 + 64 + lane]; }
        const float mean = wave_sum(o0 + o1) * (1.0f / 128.0f); o0 -= mean; o1 -= mean;
        const float rstd = 1.0f / sqrtf(wave_sum(o0 * o0 + o1 * o1) * (1.0f / 128.0f) + NORM_EPS);
        const bf16_t* gp = F.PB + row * INW + C_G + h * 128; const float* gn = F.ret_norm_g + l * 512 + h * 128;
        bf16_t* mo = F.MIX + row * D + 1024 + h * 128;
        mo[lane] = (bf16_t)(pk2(o0 * rstd * gn[lane] * silu_f(bf2f(gp[lane])), 0.f) & 0xffffu);
        mo[lane + 64] = (bf16_t)(pk2(o1 * rstd * gn[lane + 64] * silu_f(bf2f(gp[lane + 64])), 0.f) & 0xffffu); }
}

DI void smisc_unit(Frame& F, int l, int s) {
    LAS float* dl = (LAS float*)F.lds; LAS float* red = dl + 512;
    const int tid = opaque_tid(), lane = tid & 63, w = __builtin_amdgcn_readfirstlane(tid >> 6); const size_t row = (size_t)MPR + s; const bf16_t* p = F.PB + row * INW;
    __syncthreads();
    {
        const int gi = tid >> 7, win = 2 << gi; const float a0 = bf2f(p[C_A + tid]);
        const float* prev = F.st_pool + ((size_t)(l * NS + s) * 15) * 512 + tid; float* po = F.out + O_POOLS + ((size_t)(l * NS + s) * 15) * 512 + tid;
        float ws = a0;
#pragma unroll
        for (int j = 0; j < 15; ++j) { const float pj = prev[(size_t)j * 512]; if (15 - j < win) ws += pj; if (j >= 1) po[(size_t)(j - 1) * 512] = pj; }
        po[(size_t)14 * 512] = a0;
        dl[tid] = ws / (float)win - a0;
    }
    {
        const float z0 = bf2f(p[C_CG + tid]) * bf2f(p[C_HH + tid]); const float* cw = F.conv_w + l * 3 * 512 + tid;
        const float* pc = F.st_conv + ((size_t)(l * NS + s) * 2) * 512 + tid; const float p0 = pc[0], p1 = pc[512];
        const float y = bf2f(p[C_BG + tid]) * (p0 * cw[0] + p1 * cw[512] + z0 * cw[1024]);
        F.MIX[row * D + 512 + tid] = (bf16_t)(pk2(y, 0.f) & 0xffffu);
        float* co = F.out + O_CONVS + ((size_t)(l * NS + s) * 2) * 512 + tid; co[0] = p1; co[512] = z0;
    }
    const float vvx = bf2f(p[C_VV + tid]);
    { const float sm = wave_sum(vvx); if (lane == 0) red[w] = sm; }
    __syncthreads();
    float mean = 0.f;
#pragma unroll
    for (int i = 0; i < 8; ++i) mean += red[i];
    mean *= (1.0f / 512.0f);
    const float dv = vvx - mean;
    { const float sq = wave_sum(dv * dv); if (lane == 0) red[8 + w] = sq; }
    {
        const int gi = tid >> 7, e = tid & 127; const bf16_t* wp = F.POOLW + ((size_t)(l * 4 + gi) * 128) * 128 + e; float y = 0.f;
#pragma unroll 8
        for (int c = 0; c < 128; ++c) y += dl[gi * 128 + c] * bf2f(wp[(size_t)c * 128]);
        F.MIX[row * D + tid] = (bf16_t)(pk2(y, 0.f) & 0xffffu);
    }
    __syncthreads();
    float var = 0.f;
#pragma unroll
    for (int i = 0; i < 8; ++i) var += red[8 + i];
    const float rstd = 1.0f / sqrtf(var * (1.0f / 512.0f) + NORM_EPS);
    const float vn = dv * rstd * F.sgu_norm_g[l * 512 + tid];
    F.out[O_SGUS + (size_t)(l * NS + s) * 512 + tid] = vn;
    const int h = tid >> 7; const float mixed = F.sgu_w[(size_t)(l * 4 + h) * 16384] * vn + F.sgu_b[(l * 4 + h) * 128];
    F.MIX[row * D + 1536 + tid] = (bf16_t)(pk2(bf2f(p[C_U + tid]) * mixed, 0.f) & 0xffffu);
}

DI void final_norm(Frame& F) {
    const int tid = opaque_tid(), lane = tid & 63, wave = __builtin_amdgcn_readfirstlane(tid >> 6);
    const int gw = F.bid * 8 + wave, NGW = F.G * 8;
    for (int m = gw; m < MV; m += NGW) { const float rs = pg8::row_rstd(F.SSQ1, m);
        const f32x4* hr = (const f32x4*)(F.H + (size_t)m * D) + lane; const f32x4* gr = (const f32x4*)F.final_g + lane;
        f32x4* o = (f32x4*)(F.out + (m < MPR ? O_YP + (size_t)m * D : O_YS + (size_t)(m - MPR) * D)) + lane;
#pragma unroll
        for (int j = 0; j < 8; ++j) o[64 * j] = hr[64 * j] * rs * gr[64 * j]; }
}

constexpr int N_PHASES = 2 + 6 * DEPTH;
__global__ void __launch_bounds__(512, 2) mk_fwd(Args args) {
    extern __shared__ __attribute__((aligned(16))) unsigned char lds[];
    Frame F;
    F.lds = (LAS unsigned char*)lds; F.misc = F.lds + MISC_OFF;
    F.G = gridDim.x; F.bid = blockIdx.x;
    unsigned char* ws = args.ws;
    F.xp = args.in[0]; F.xs = args.in[1]; F.st_pool = args.in[2]; F.st_conv = args.in[3]; F.st_ret = args.in[4]; F.norm1_g = args.in[5]; F.w_in = args.in[6];
    F.pool_w = args.in[7]; F.pool_scale = args.in[8]; F.conv_w = args.in[9]; F.ret_norm_g = args.in[10]; F.sgu_norm_g = args.in[11]; F.sgu_w = args.in[12]; F.sgu_b = args.in[13];
    F.w_out = args.in[14]; F.norm2_g = args.in[15]; F.w_gu = args.in[16]; F.w_dn = args.in[17]; F.final_g = args.in[18]; F.out = args.out;
    F.ROPE = (float*)(ws + WS_ROPE); F.SSQ1 = (float*)(ws + WS_SSQ1); F.SSQ2 = (float*)(ws + WS_SSQ2); F.H = (float*)(ws + WS_H); F.KV = (float*)(ws + WS_KV);
    F.POOLW = (bf16_t*)(ws + WS_POOLW); F.SGUW = (bf16_t*)(ws + WS_SGUW); F.WIN = (bf16_t*)(ws + WS_WIN); F.WOUT = (bf16_t*)(ws + WS_WOUT); F.WGU = (bf16_t*)(ws + WS_WGU); F.WDN = (bf16_t*)(ws + WS_WDN);
    F.HB = (bf16_t*)(ws + WS_HB); F.PB = (bf16_t*)(ws + WS_PB); F.MIX = (bf16_t*)(ws + WS_MIX); F.ACT = (bf16_t*)(ws + WS_ACT);
    for (int u = threadIdx.x; u < (LDS_BYTES - LDSCTL_OFF) / 4; u += 512) ((LAS unsigned*)(F.lds + LDSCTL_OFF))[u] = 0u;
    __syncthreads();
    XcdBarrier bar; bar.bar = (unsigned*)(ws + WS_CTL) + CW_BAR; bar.x = 0; bar.st = nullptr;
    if (MK_N_LAUNCHES == 1) bar = xcd_barrier_post((unsigned*)(ws + WS_CTL) + CW_BAR, (volatile LAS unsigned*)(F.lds + LDSCTL_OFF));
    const int lo = args.ph_lo, hi = args.ph_hi;
#define IN(k) (lo <= (k) && (k) < hi)
#define SEAM(k) do { if (IN(k) && IN((k) + 1)) xcd_barrier(bar); } while (0)

    if (IN(0)) { p0_prologue(F); } SEAM(0);
    for (int l = 0; l < DEPTH; ++l) {
        const int p = 1 + 6 * l;
        if (IN(p)) {
            pg8::Gemm g{F.HB, F.WIN + (size_t)l * INW * D, MP, INW, D}; pg8::StaticOrder S; S.init(MP, INW, F.G, F.bid);
            pg8::EpiIn E{F.PB, F.SSQ1};
            pg8::gemm_phase<pg8::EpiIn, pg8::StaticOrder, true, true>(F.lds, F.misc, g, S, E);
        } SEAM(p);
        if (IN(p + 1)) {
            const int NJ = 256 + 512 + 128;
            for (int j = F.bid; j < NJ; j += F.G) {
                if (j < 256) ret_kv_unit(F, j >> 6, (j >> 4) & 3, j & 15);
                else if (j < 768) { const int k = j - 256; sret_unit(F, l, k >> 2, k & 3); }
                else smisc_unit(F, l, j - 768);
            }
            conv_flat(F, l);
        } SEAM(p + 1);
        if (IN(p + 2)) {
            const int NJ = 768;
            for (int j = F.bid; j < NJ; j += F.G) {
                if (j < 256) ret_out_unit(F, l, j >> 6, (j >> 4) & 3, 15 - (j & 15));
                else if (j < 512) { const int k = j - 256; pool_unit(F, l, k >> 6, (k >> 2) & 15, k & 3); }
                else { const int k = j - 512; sgu_unit(F, l, k >> 6, (k >> 2) & 15, k & 3); }
            }
            ret_final_flat(F, l);
            __syncthreads();
        } SEAM(p + 2);
        if (IN(p + 3)) {
            pg8::Gemm g{F.MIX, F.WOUT + (size_t)l * D * D, MP, D, D}; pg8::StaticOrder S; S.init(MP, D, F.G, F.bid);
            pg8::EpiRes E{l == 0 ? F.xp : F.H, l == 0 ? F.xs - (size_t)MPR * D : F.H, F.H, F.HB, F.SSQ2};
            pg8::gemm_phase<pg8::EpiRes, pg8::StaticOrder, true, true>(F.lds, F.misc, g, S, E);
        } SEAM(p + 3);
        if (IN(p + 4)) {
            pg8::Gemm g{F.HB, F.WGU + (size_t)l * GU * D, MP, GU, D}; pg8::StaticOrder S; S.init(MP, GU, F.G, F.bid);
            pg8::EpiGu E{F.ACT, F.SSQ2};
            pg8::gemm_phase<pg8::EpiGu, pg8::StaticOrder, true, true>(F.lds, F.misc, g, S, E);
        } SEAM(p + 4);
        if (IN(p + 5)) {
            pg8::Gemm g{F.ACT, F.WDN + (size_t)l * D * FF, MP, D, FF}; pg8::StaticOrder S; S.init(MP, D, F.G, F.bid);
            pg8::EpiRes E{F.H, F.H, F.H, F.HB, F.SSQ1};
            pg8::gemm_phase<pg8::EpiRes, pg8::StaticOrder, true, true>(F.lds, F.misc, g, S, E);
        } SEAM(p + 5);
    }
    if (IN(N_PHASES - 1)) final_norm(F);
#undef IN
#undef SEAM
}

extern "C" void kernel_launch(void* const* d_in, const int* in_sizes, int n_in, void* d_out, int out_size, void* d_ws, size_t ws_size, hipStream_t stream) {
    static int grid = 0;
    if (grid == 0) {
        if (n_in != 19 || (size_t)out_size != O_END || ws_size < WS_END) { fprintf(stderr, "kernel_launch: unexpected sizes (n_in %d, out %d, ws %zu)\n", n_in, out_size, ws_size); grid = -1; return; }
        int dev = 0, cus = 0, per_cu = 0;
        if (hipGetDevice(&dev) != hipSuccess || hipDeviceGetAttribute(&cus, hipDeviceAttributeMultiprocessorCount, dev) != hipSuccess) { grid = -1; return; }
        if (hipFuncSetAttribute((const void*)mk_fwd, hipFuncAttributeMaxDynamicSharedMemorySize, LDS_BYTES) != hipSuccess) { fprintf(stderr, "kernel_launch: hipFuncSetAttribute failed\n"); grid = -1; return; }
        if (hipOccupancyMaxActiveBlocksPerMultiprocessor(&per_cu, (const void*)mk_fwd, 512, LDS_BYTES) != hipSuccess || per_cu < 1) { fprintf(stderr, "kernel_launch: occupancy query says %d blocks per CU\n", per_cu); per_cu = 1; }
        (void)hipGetLastError();
        grid = cus;
    }
    if (grid < 0) return;
    (void)hipMemsetAsync((char*)d_ws + WS_CTL, 0, CTL_ZERO_BYTES, stream);
    Args a{};
    for (int i = 0; i < 19; ++i) a.in[i] = (const float*)d_in[i];
    a.out = (float*)d_out; a.ws = (unsigned char*)d_ws;
    if (MK_N_LAUNCHES == 1) { a.ph_lo = 0; a.ph_hi = N_PHASES; a.li = 0; hipLaunchKernelGGL(mk_fwd, dim3(grid), dim3(512), LDS_BYTES, stream, a); }
    else for (int li = 0; li < N_PHASES; ++li) { a.ph_lo = li; a.ph_hi = li + 1; a.li = li; hipLaunchKernelGGL(mk_fwd, dim3(grid), dim3(512), LDS_BYTES, stream, a); }
}
```

```cpp
#include <hip/hip_runtime.h>
#include <cstdio>
#include <cstdint>

#ifndef MK_N_LAUNCHES
#define MK_N_LAUNCHES 1
#endif

#ifndef PROBE_DUP
#define PROBE_DUP (-1)
#endif
#define LAS __attribute__((address_space(3)))
#define GAS __attribute__((address_space(1)))
#define DI __device__ __forceinline__

typedef unsigned short bf16_t;
typedef short bf16x8 __attribute__((ext_vector_type(8)));
typedef short s16x4 __attribute__((ext_vector_type(4)));
typedef float f32x4 __attribute__((ext_vector_type(4)));
typedef float f32x2 __attribute__((ext_vector_type(2)));
typedef unsigned u32x4 __attribute__((ext_vector_type(4)));
typedef unsigned u32x2 __attribute__((ext_vector_type(2)));
typedef __bf16 bf16x2_t __attribute__((ext_vector_type(2)));

constexpr int D = 2048, INW = 5120, FF = 5632, GU = 2 * FF;
constexpr int NB = 4, SEQ = 2048, MPR = NB * SEQ  , NS = 128, MV = MPR + NS  , MP = 8448  ;
constexpr int DEPTH = 2, NCH = SEQ / 128  ;
constexpr int C_A = 0, C_BG = 512, C_CG = 1024, C_HH = 1536, C_Q = 2048, C_K = 2560, C_V = 3072, C_G = 3584, C_U = 4096, C_VV = 4608;
constexpr float NORM_EPS = 1e-6f;
constexpr int ROPE_SPOS = 2048;
constexpr size_t O_YP = 0, O_YS = 16777216, O_POOLP = 17039360, O_POOLS = 17100800, O_CONVP = 19066880, O_CONVS = 19075072,
                 O_RETP = 19337216, O_RETS = 19861504, O_SGUP = 36638720, O_SGUS = 37163008, O_END = 37294080;

constexpr size_t MiB = 1u << 20;
constexpr size_t WS_CTL = 0, CTL_ZERO_BYTES = 1 * MiB;
constexpr size_t WS_ROPE = 1 * MiB;
constexpr size_t WS_POOLW = 3 * MiB;
constexpr size_t WS_SGUW = 4 * MiB;
constexpr size_t WS_SSQ1 = 5 * MiB, WS_SSQ2 = 6 * MiB;
constexpr size_t WS_SSQS1 = 7 * MiB, WS_SSQS2 = 7 * MiB + 65536;
constexpr size_t WS_WIN = 8 * MiB;
constexpr size_t WS_WOUT = 48 * MiB;
constexpr size_t WS_WGU = 64 * MiB;
constexpr size_t WS_WDN = 152 * MiB;
constexpr size_t WS_H = 196 * MiB;
constexpr size_t WS_HB = 262 * MiB;
constexpr size_t WS_PB = 295 * MiB;
constexpr size_t WS_MIX = 378 * MiB;
constexpr size_t WS_ACT = 411 * MiB;
constexpr size_t WS_KV = 502 * MiB;
constexpr size_t WS_SB = 519 * MiB;
constexpr size_t WS_DUMH = 528 * MiB, WS_DUMHB = 594 * MiB, WS_DUMSSQ = 627 * MiB;
constexpr size_t WS_END = (PROBE_DUP >= 0) ? 628 * MiB : 527 * MiB;
constexpr int CW_BAR = 4096;

constexpr int RING_BYTES = 131072;
constexpr int MISC_OFF = RING_BYTES;
constexpr int LDSCTL_OFF = MISC_OFF + 4096;
constexpr int LDS_BYTES = 147456;

DI float bf2f(unsigned short b) { return __uint_as_float(((unsigned)b) << 16); }
DI float bflo(unsigned w) { return __uint_as_float(w << 16); }
DI float bfhi(unsigned w) { return __uint_as_float(w & 0xffff0000u); }
DI unsigned pk2(float lo, float hi) { f32x2 v = {lo, hi}; bf16x2_t b = __builtin_convertvector(v, bf16x2_t); return __builtin_bit_cast(unsigned, b); }
DI float wave_sum(float v) {
#pragma unroll
    for (int o = 1; o < 64; o <<= 1) v += __shfl_xor(v, o);
    return v;
}
DI float silu_f(float g) { return g / (1.0f + __expf(-g)); }
DI int opaque_sgpr(int v) { asm volatile("" : "+s"(v)); return v; }
DI int opaque_tid() { int t = threadIdx.x; asm volatile("" : "+v"(t)); return t; }

namespace pg8 {
constexpr int BM = 256, BK = 64, HALF = 128, HTB = HALF * BK * 2  , STAGE_BYTES = 8 * HTB, NXCD = 8, WGM = 8;
__host__ __device__ __forceinline__ int lds_byte(int r, int c) { const int st = (r >> 4) * 2 + (c >> 5), rr = r & 15, cc = c & 31, ob = rr * 64 + cc * 2; return st * 1024 + (ob ^ (((ob >> 9) & 1) << 5)); }
__host__ __device__ __forceinline__ void stage_rc(int b, int& R, int& C) { const int st = b / 1024, sb = b % 1024, swz = sb ^ (((sb >> 9) & 1) << 5); R = (st >> 1) * 16 + swz / 64; C = (st & 1) * 32 + (swz % 64) / 2; }
__host__ __device__ __forceinline__ int perm32(int rho) { const int n = rho >> 4, i = rho & 15; return 8 * (i >> 2) + 4 * n + (i & 3); }

struct Unit { int pm, pn; };
struct Gemm { const bf16_t* A; const bf16_t* Bt; int M, N, K; };

struct StaticOrder {
    int nM, nN, nwg, G, c;
    __host__ __device__ void init(int M, int N, int G_, int c_) { nM = M / BM; nN = N / BM; nwg = nM * nN; G = G_; c = c_; }
    __host__ __device__ bool next(int i, Unit& u) const {
        const long L = (long)i * G + c; if (L >= nwg) return false;
        int wgid = (int)L; { const int q = nwg / NXCD, r = nwg % NXCD, xcd = wgid % NXCD, off = wgid / NXCD; wgid = (xcd < r ? xcd * (q + 1) : r * (q + 1) + (xcd - r) * q) + off; }
        const int nig = WGM * nN, gid = wgid / nig, fm = gid * WGM, gsz = (nM - fm) < WGM ? (nM - fm) : WGM;
        u.pm = fm + ((wgid % nig) % gsz); u.pn = (wgid % nig) / gsz; return true;
    }
    __device__ __forceinline__ void a_ready(const Unit&) const {}
    __device__ __forceinline__ void done(const Unit&) const {}
};

DI float row_rstd(const float* ssq, const float* ssqs, int row) {
    float ss;
    if (row < MPR) { const f32x4 s0 = *(const f32x4*)(ssq + (size_t)row * 8), s1 = *(const f32x4*)(ssq + (size_t)row * 8 + 4);
        ss = ((s0[0] + s0[1]) + (s0[2] + s0[3])) + ((s1[0] + s1[1]) + (s1[2] + s1[3])); }
    else { const f32x4* p = (const f32x4*)(ssqs + (size_t)(row - MPR) * 128); f32x4 a = p[0];
#pragma unroll
        for (int i = 1; i < 32; ++i) a += p[i];
        ss = (a[0] + a[1]) + (a[2] + a[3]); }
    return 1.0f / sqrtf(ss * (1.0f / (float)D) + NORM_EPS);
}
struct EpiIn {
    static constexpr bool PERM = true;
    bf16_t* P; const float* ssq; const float* ssqs;
    DI void operator()(const f32x4 (&acc)[2][2][4][2], const Unit& u, int wr, int wc, int fr, int fq, LAS unsigned char*, int) const {
        const int row0 = u.pm * BM + wr * 64 + fr, col0 = u.pn * BM + wc * 32 + 8 * fq;
#pragma unroll
        for (int ai = 0; ai < 2; ++ai)
#pragma unroll
            for (int m = 0; m < 4; ++m) { const int row = row0 + ai * HALF + m * 16;
                if (row < MV) { const float rs = row_rstd(ssq, ssqs, row); bf16_t* rowp = P + (size_t)row * INW + col0;
#pragma unroll
                    for (int bj = 0; bj < 2; ++bj) { const f32x4 v0 = acc[ai][bj][m][0] * rs, v1 = acc[ai][bj][m][1] * rs;
                        u32x4 w; w.x = pk2(v0[0], v0[1]); w.y = pk2(v0[2], v0[3]); w.z = pk2(v1[0], v1[1]); w.w = pk2(v1[2], v1[3]);
                        *(u32x4*)(rowp + bj * HALF) = w; } } }
    }
};
struct EpiGu {
    static constexpr bool PERM = true;
    bf16_t* ACT; const float* ssq; const float* ssqs;
    DI void operator()(const f32x4 (&acc)[2][2][4][2], const Unit& u, int wr, int wc, int fr, int fq, LAS unsigned char*, int) const {
        const int row0 = u.pm * BM + wr * 64 + fr, col0 = u.pn * HALF + wc * 32 + 8 * fq;
#pragma unroll
        for (int ai = 0; ai < 2; ++ai)
#pragma unroll
            for (int m = 0; m < 4; ++m) { const int row = row0 + ai * HALF + m * 16;
                if (row < MV) { const float rs = row_rstd(ssq, ssqs, row);
                    float o[8];
#pragma unroll
                    for (int n = 0; n < 2; ++n)
#pragma unroll
                        for (int j = 0; j < 4; ++j) { const float g = acc[ai][0][m][n][j] * rs, up = acc[ai][1][m][n][j] * rs; o[n * 4 + j] = silu_f(g) * up; }
                    u32x4 w; w.x = pk2(o[0], o[1]); w.y = pk2(o[2], o[3]); w.z = pk2(o[4], o[5]); w.w = pk2(o[6], o[7]);
                    *(u32x4*)(ACT + (size_t)row * FF + col0) = w; } }
    }
};
struct EpiRes {
    static constexpr bool PERM = true;
    const float* base;
    float* H; bf16_t* HB; float* ssq_out;
    DI void operator()(const f32x4 (&acc)[2][2][4][2], const Unit& u, int wr, int wc, int fr, int fq, LAS unsigned char* misc, int tid) const {
        LAS float* part = (LAS float*)misc;
        const int col0 = u.pn * BM + wc * 32 + 8 * fq;
#pragma unroll
        for (int ai = 0; ai < 2; ++ai)
#pragma unroll
            for (int m = 0; m < 4; ++m) { const int rl = ai * HALF + wr * 64 + m * 16 + fr, row = u.pm * BM + rl; float ss = 0.f;
                { const size_t off = (size_t)row * D + col0; const float* bp = base + off;
#pragma unroll
                    for (int bj = 0; bj < 2; ++bj) { const f32x4 b0 = *(const f32x4*)(bp + bj * HALF), b1 = *(const f32x4*)(bp + bj * HALF + 4);
                        const f32x4 h0 = b0 + acc[ai][bj][m][0], h1 = b1 + acc[ai][bj][m][1];
                        *(f32x4*)(H + off + bj * HALF) = h0; *(f32x4*)(H + off + bj * HALF + 4) = h1;
                        u32x4 w; w.x = pk2(h0[0], h0[1]); w.y = pk2(h0[2], h0[3]); w.z = pk2(h1[0], h1[1]); w.w = pk2(h1[2], h1[3]);
                        *(u32x4*)(HB + off + bj * HALF) = w;
                        ss += ((h0[0] * h0[0] + h0[1] * h0[1]) + (h0[2] * h0[2] + h0[3] * h0[3])) + ((h1[0] * h1[0] + h1[1] * h1[1]) + (h1[2] * h1[2] + h1[3] * h1[3])); } }
                ss += __shfl_xor(ss, 16); ss += __shfl_xor(ss, 32);
                if (fq == 0) part[rl * 4 + wc] = ss; }
        asm volatile("s_waitcnt lgkmcnt(0)" ::: "memory"); __builtin_amdgcn_s_barrier(); asm volatile("" ::: "memory");
        if (tid < 256) { const int row = u.pm * BM + tid; const LAS f32x4* p4 = (const LAS f32x4*)(part + tid * 4); const f32x4 p = *p4;
            __hip_atomic_store(ssq_out + (size_t)row * 8 + u.pn, (p[0] + p[1]) + (p[2] + p[3]), __ATOMIC_RELAXED, __HIP_MEMORY_SCOPE_AGENT); }
    }
};

template <class Epi, class Sched, bool ALIGN_EPI, bool SP2>
__device__ __forceinline__ void gemm_phase(LAS unsigned char* lds, LAS unsigned char* misc, const Gemm g, const Sched& S, const Epi& E) {
    const int tid = opaque_tid(), wid = __builtin_amdgcn_readfirstlane(tid >> 6), lane = tid & 63, wr = wid >> 2, wc = wid & 3, fr = lane & 15, fq = lane >> 4;
    const int K = g.K, nt = K / BK;
    unsigned voffA[2], voffB[2];
#pragma unroll
    for (int i = 0; i < 2; ++i) { int R, C; stage_rc(tid * 16 + i * 8192, R, C); const int Rb = Epi::PERM ? ((R & ~31) + perm32(R & 31)) : R;
        voffA[i] = (unsigned)(R * K + C) * 2u; voffB[i] = (unsigned)(Rb * K + C) * 2u; }
    const size_t kstep = (size_t)(BK * 2);
    const size_t hstep = (size_t)HALF * K * 2;
    const size_t tstep = 2 * hstep;
    const unsigned ldsw = (unsigned)wid * 1024u;
    const int aoff = lds_byte(wr * 64 + fr, fq * 8), boff = lds_byte(wc * 32 + fr, fq * 8);
#define PG8_SA(b, h) (((b) * 2 + (h)) * HTB)
#define PG8_SB(b, h) ((4 + (b) * 2 + (h)) * HTB)
#define PG8_STAGE(bufoff, gbase, voff) do { _Pragma("unroll") for (int _i = 0; _i < 2; ++_i) \
        __builtin_amdgcn_global_load_lds((const unsigned*)((const char*)(gbase) + (voff)[_i]), (LAS unsigned*)(lds + (bufoff) + ldsw + _i * 8192), 16, 0, 0); } while (0)
#define PG8_LDA(dst, b, h) do { _Pragma("unroll") for (int m = 0; m < 4; ++m) _Pragma("unroll") for (int k = 0; k < 2; ++k) dst[m][k] = *(const LAS bf16x8*)(lds + PG8_SA(b, h) + aoff + m * 2048 + k * 1024); } while (0)
#define PG8_LDB(dst, b, h) do { _Pragma("unroll") for (int n = 0; n < 2; ++n) _Pragma("unroll") for (int k = 0; k < 2; ++k) dst[n][k] = *(const LAS bf16x8*)(lds + PG8_SB(b, h) + boff + n * 2048 + k * 1024); } while (0)
#define PG8_MMA(ai, bj, At, Bt) do { __builtin_amdgcn_s_setprio(1); _Pragma("unroll") for (int m = 0; m < 4; ++m) _Pragma("unroll") for (int n = 0; n < 2; ++n) _Pragma("unroll") for (int k = 0; k < 2; ++k) \
        acc[ai][bj][m][n] = __builtin_amdgcn_mfma_f32_16x16x32_bf16(Bt[n][k], At[m][k], acc[ai][bj][m][n], 0, 0, 0); __builtin_amdgcn_s_setprio(0); } while (0)
#define PG8_WAIT_V(n) asm volatile("s_waitcnt vmcnt(" #n ")" ::: "memory")
#define PG8_WAIT_L(n) asm volatile("s_waitcnt lgkmcnt(" #n ")" ::: "memory")
#define PG8_BAR __builtin_amdgcn_s_barrier()
#define PG8_SCHED __builtin_amdgcn_sched_barrier(0)
    Unit cur, nxt; int ui = 0;
    if (!S.next(0, cur)) return;
    f32x4 acc[2][2][4][2];
#pragma unroll
    for (int a = 0; a < 2; ++a)
#pragma unroll
        for (int b = 0; b < 2; ++b)
#pragma unroll
            for (int m = 0; m < 4; ++m)
#pragma unroll
                for (int n = 0; n < 2; ++n) acc[a][b][m][n] = (f32x4){0.f, 0.f, 0.f, 0.f};
    bf16x8 At[4][2], B0[2][2], B1[2][2];
    const char* cA = (const char*)g.A + (size_t)cur.pm * tstep; const char* cB = (const char*)g.Bt + (size_t)cur.pn * tstep;
    S.a_ready(cur);
    if constexpr (SP2) {
        PG8_STAGE(PG8_SB(0, 0), cB, voffB); PG8_STAGE(PG8_SB(0, 1), cB + hstep, voffB); PG8_STAGE(PG8_SA(0, 0), cA, voffA); PG8_STAGE(PG8_SA(0, 1), cA + hstep, voffA);
        if (wr == 1) PG8_BAR;
        PG8_WAIT_V(2); PG8_BAR;
        PG8_STAGE(PG8_SB(1, 0), cB + kstep, voffB); PG8_STAGE(PG8_SA(1, 0), cA + kstep, voffA); PG8_STAGE(PG8_SB(1, 1), cB + hstep + kstep, voffB);
        PG8_WAIT_V(6); PG8_BAR;
    } else {
        PG8_STAGE(PG8_SB(0, 0), cB, voffB); PG8_STAGE(PG8_SA(0, 0), cA, voffA); PG8_STAGE(PG8_SB(0, 1), cB + hstep, voffB); PG8_STAGE(PG8_SA(0, 1), cA + hstep, voffA);
        if (wr == 1) PG8_BAR;
        PG8_WAIT_V(4); PG8_BAR;
        PG8_STAGE(PG8_SB(1, 0), cB + kstep, voffB); PG8_STAGE(PG8_SA(1, 0), cA + kstep, voffA); PG8_STAGE(PG8_SB(1, 1), cB + hstep + kstep, voffB);
        PG8_WAIT_V(6); PG8_BAR;
    }
    for (;;) {
        const bool has_next = S.next(ui + 1, nxt);
        const char* nA = has_next ? (const char*)g.A + (size_t)nxt.pm * tstep : cA; const char* nB = has_next ? (const char*)g.Bt + (size_t)nxt.pn * tstep : cB;
        for (int t = 0; t < nt; t += 2) {
            const bool last = (t == nt - 2);
            const char* a1 = cA + (size_t)(t + 1) * kstep;
            const char* a2 = last ? nA : cA + (size_t)(t + 2) * kstep; const char* b2 = last ? nB : cB + (size_t)(t + 2) * kstep;
            const char* a3 = a2 + kstep; const char* b3 = b2 + kstep;
            if (last && has_next) S.a_ready(nxt);
            if constexpr (SP2) {
            PG8_LDB(B0, 0, 0); PG8_LDB(B1, 0, 1); PG8_SCHED; PG8_LDA(At, 0, 0); PG8_STAGE(PG8_SA(1, 1), a1 + hstep, voffA);
            PG8_WAIT_V(8); PG8_WAIT_L(0); PG8_BAR; PG8_MMA(0, 0, At, B0); PG8_MMA(0, 1, At, B1); PG8_BAR; PG8_SCHED;
            PG8_LDA(At, 0, 1); PG8_STAGE(PG8_SB(0, 0), b2, voffB); PG8_STAGE(PG8_SB(0, 1), b2 + hstep, voffB); PG8_STAGE(PG8_SA(0, 0), a2, voffA);
            PG8_WAIT_V(8); PG8_WAIT_L(0); PG8_BAR; PG8_MMA(1, 0, At, B0); PG8_MMA(1, 1, At, B1); PG8_BAR; PG8_SCHED;
            PG8_LDB(B0, 1, 0); PG8_LDB(B1, 1, 1); PG8_SCHED; PG8_LDA(At, 1, 0); PG8_STAGE(PG8_SA(0, 1), a2 + hstep, voffA);
            PG8_WAIT_V(8); PG8_WAIT_L(0); PG8_BAR; PG8_MMA(0, 0, At, B0); PG8_MMA(0, 1, At, B1); PG8_BAR; PG8_SCHED;
            PG8_LDA(At, 1, 1); PG8_STAGE(PG8_SB(1, 0), b3, voffB); PG8_STAGE(PG8_SB(1, 1), b3 + hstep, voffB); PG8_STAGE(PG8_SA(1, 0), a3, voffA);
            PG8_WAIT_V(8); PG8_WAIT_L(0); PG8_BAR; PG8_MMA(1, 0, At, B0); PG8_MMA(1, 1, At, B1); PG8_BAR; PG8_SCHED;
            } else {
            PG8_LDB(B0, 0, 0); PG8_SCHED; PG8_LDA(At, 0, 0); PG8_STAGE(PG8_SA(1, 1), a1 + hstep, voffA);
            PG8_WAIT_L(8); PG8_BAR; PG8_WAIT_L(0); PG8_MMA(0, 0, At, B0); PG8_BAR; PG8_SCHED;
            PG8_LDB(B1, 0, 1); PG8_STAGE(PG8_SB(0, 0), b2, voffB);
            PG8_BAR; PG8_WAIT_L(0); PG8_MMA(0, 1, At, B1); PG8_BAR;
            PG8_LDA(At, 0, 1); PG8_STAGE(PG8_SA(0, 0), a2, voffA);
            PG8_BAR; PG8_WAIT_L(0); PG8_MMA(1, 0, At, B0); PG8_BAR; PG8_SCHED;
            PG8_STAGE(PG8_SB(0, 1), b2 + hstep, voffB);
            PG8_WAIT_V(6); PG8_BAR; PG8_MMA(1, 1, At, B1); PG8_BAR;
            PG8_LDB(B0, 1, 0); PG8_SCHED; PG8_LDA(At, 1, 0); PG8_STAGE(PG8_SA(0, 1), a2 + hstep, voffA);
            PG8_WAIT_L(8); PG8_BAR; PG8_WAIT_L(0); PG8_MMA(0, 0, At, B0); PG8_BAR; PG8_SCHED;
            PG8_LDB(B1, 1, 1); PG8_STAGE(PG8_SB(1, 0), b3, voffB);
            PG8_BAR; PG8_WAIT_L(0); PG8_MMA(0, 1, At, B1); PG8_BAR;
            PG8_LDA(At, 1, 1); PG8_STAGE(PG8_SA(1, 0), a3, voffA);
            PG8_BAR; PG8_WAIT_L(0); PG8_MMA(1, 0, At, B0); PG8_BAR; PG8_SCHED;
            PG8_STAGE(PG8_SB(1, 1), b3 + hstep, voffB);
            PG8_WAIT_V(6); PG8_BAR; PG8_MMA(1, 1, At, B1); PG8_BAR;
            }
        }
        if constexpr (ALIGN_EPI) { if (wr == 0) PG8_BAR; }
        E(acc, cur, wr, wc, fr, fq, misc, tid); S.done(cur);
        if (!has_next) break;
#pragma unroll
        for (int a = 0; a < 2; ++a)
#pragma unroll
            for (int b = 0; b < 2; ++b)
#pragma unroll
                for (int m = 0; m < 4; ++m)
#pragma unroll
                    for (int n = 0; n < 2; ++n) acc[a][b][m][n] = (f32x4){0.f, 0.f, 0.f, 0.f};
        cur = nxt; cA = nA; cB = nB; ++ui;
        if constexpr (ALIGN_EPI) { if (wr == 1) PG8_BAR; }
    }
    PG8_WAIT_V(0);
    if constexpr (!ALIGN_EPI) { if (wr == 0) PG8_BAR; }
    PG8_BAR;
#undef PG8_SA
#undef PG8_SB
#undef PG8_STAGE
#undef PG8_LDA
#undef PG8_LDB
#undef PG8_MMA
#undef PG8_WAIT_V
#undef PG8_WAIT_L
#undef PG8_BAR
#undef PG8_SCHED
}
}

#define XB_TMO      128
#define XB_XCNT(j)  (256  + 64 * (j))
#define XB_XSUB(j)  (1280 + 64 * (j))
#define XB_XGEN(j)  (2304 + 64 * (j))
#define XB_TOP      3328
#define XB_TOPGEN   3392
#define XCD_BAR_WORDS 3456
#define XB_SPIN_CAP (1u << 18)

DI unsigned xb_ld(unsigned* p)              { return __hip_atomic_load(p, __ATOMIC_RELAXED, __HIP_MEMORY_SCOPE_AGENT); }
DI unsigned xb_add(unsigned* p, unsigned v) { return __hip_atomic_fetch_add(p, v, __ATOMIC_RELAXED, __HIP_MEMORY_SCOPE_AGENT); }
DI unsigned xb_xcc_id() { return (unsigned)__builtin_amdgcn_s_getreg((3 << 11) | 20) & 0xFu; }
#define XB_SPIN(cond, bar) do { unsigned _sp = 0; while (cond) { __builtin_amdgcn_s_sleep(1); \
    if ((++_sp & 255u) == 0u) { if (xb_ld(&(bar)[XB_TMO])) break; if (_sp > XB_SPIN_CAP) { atomicAdd(&(bar)[XB_TMO], 1u); break; } } } } while (0)

struct XcdBarrier { unsigned* bar; unsigned x; volatile LAS unsigned* st; };

DI XcdBarrier xcd_barrier_post(unsigned* bar, volatile LAS unsigned* st) {
    XcdBarrier b; b.bar = bar; b.x = xb_xcc_id(); b.st = st;
    if (threadIdx.x == 0) (void)xb_add(&bar[XB_XCNT(b.x)], 1u);
    return b;
}
DI void xcd_barrier_complete(unsigned* bar, unsigned x, unsigned& nloc, unsigned& nx) {
    const unsigned G = gridDim.x * gridDim.y * gridDim.z;
    unsigned sum, cnt, mine, sp = 0u;
    for (;;) {
        sum = 0u; cnt = 0u; mine = 0u;
#pragma unroll
        for (unsigned j = 0; j < 16; ++j) { const unsigned c = xb_ld(&bar[XB_XCNT(j)]); sum += c; cnt += (c > 0u) ? 1u : 0u; mine = (j == x) ? c : mine; }
        if (sum == G) break;
        __builtin_amdgcn_s_sleep(1);
        if ((++sp & 255u) == 0u) { if (xb_ld(&bar[XB_TMO])) break; if (sp > XB_SPIN_CAP) { atomicAdd(&bar[XB_TMO], 1u); break; } }
    }
    nloc = mine > 0u ? mine : 1u; nx = cnt > 0u ? cnt : 1u;
}
DI void xcd_barrier(const XcdBarrier& b) {
    asm volatile("s_waitcnt vmcnt(0)" ::: "memory");
    __syncthreads();
    if (threadIdx.x == 0) {
        unsigned* bar = b.bar; asm volatile("" : "+s"(bar));
        __builtin_amdgcn_s_waitcnt(0);
        unsigned nloc = b.st[0], nx = b.st[1];
        if (nloc == 0u) { xcd_barrier_complete(bar, b.x, nloc, nx); b.st[0] = nloc; b.st[1] = nx; }
        const unsigned old = xb_add(&bar[XB_XSUB(b.x)], 1u);
        const unsigned gen = old / nloc;
        if (old + 1u == (gen + 1u) * nloc) {
            __builtin_amdgcn_fence(__ATOMIC_RELEASE, "agent");
            asm volatile("s_waitcnt vmcnt(0)" ::: "memory");
            const unsigned og = xb_add(&bar[XB_TOP], 1u);
            const unsigned tg = og / nx;
            if (og + 1u == (tg + 1u) * nx) xb_add(&bar[XB_TOPGEN], 1u);
            else XB_SPIN(xb_ld(&bar[XB_TOPGEN]) == tg, bar);
            __builtin_amdgcn_fence(__ATOMIC_ACQUIRE, "agent");
            xb_add(&bar[XB_XGEN(b.x)], 1u);
            asm volatile("s_waitcnt vmcnt(0)" ::: "memory");
        } else {
            XB_SPIN(xb_ld(&bar[XB_XGEN(b.x)]) == gen, bar);
            __builtin_amdgcn_fence(__ATOMIC_ACQUIRE, "agent");
            asm volatile("s_waitcnt vmcnt(0)" ::: "memory");
        }
    }
    __syncthreads();
}

struct Args {
    const float* in[19]; float* out; unsigned char* ws; int ph_lo, ph_hi, li, pad;
};
struct Frame {
    LAS unsigned char* lds; LAS unsigned char* misc;
    int G, bid;
    const float *xp, *xs, *st_pool, *st_conv, *st_ret, *norm1_g, *w_in, *pool_w, *pool_scale, *conv_w, *ret_norm_g, *sgu_norm_g, *sgu_w, *sgu_b, *w_out, *norm2_g, *w_gu, *w_dn, *final_g;
    float* out;
    float *ROPE, *SSQ1, *SSQ2, *SSQS1, *SSQS2, *H, *KV;
    bf16_t *POOLW, *SGUW, *WIN, *WOUT, *WGU, *WDN, *HB, *PB, *MIX, *ACT, *SB;
};

DI unsigned off_b(unsigned row, unsigned ch) { return 256u * row + 16u * (ch ^ (((row & 3u) << 2) | ((row >> 2) & 3u))); }
DI bf16x8 lds_rowfrag(const LAS unsigned char* tile, int lane, int rb, int s) { return *(const LAS bf16x8*)(tile + off_b((unsigned)((lane & 15) + 16 * rb), (unsigned)(4 * s + (lane >> 4)))); }
DI bf16x8 lds_trfrag(const LAS unsigned char* tile, int lane, int c, int ks) {
    const unsigned g = lane >> 4, q = (lane & 15) >> 2, p = lane & 3;
    const unsigned a0 = off_b(32u * ks + 8u * g + q, 2u * c + (p >> 1)) + 8u * (p & 1);
    const unsigned a1 = off_b(32u * ks + 8u * g + 4u + q, 2u * c + (p >> 1)) + 8u * (p & 1);
    const s16x4 lo = __builtin_amdgcn_ds_read_tr16_b64_v4i16((LAS s16x4*)(tile + a0));
    const s16x4 hi = __builtin_amdgcn_ds_read_tr16_b64_v4i16((LAS s16x4*)(tile + a1));
    return __builtin_shufflevector(lo, hi, 0, 1, 2, 3, 4, 5, 6, 7);
}
#define MFMA16(a, b, c) __builtin_amdgcn_mfma_f32_16x16x32_bf16((a), (b), (c), 0, 0, 0)

constexpr float LG2_GAMMA[4] = {-0.04580368961312479f, -0.02272007650008353f, -0.011315313227834146f, -0.005646563141142063f};
DI float lg2_gamma(int h) { return h == 0 ? LG2_GAMMA[0] : h == 1 ? LG2_GAMMA[1] : h == 2 ? LG2_GAMMA[2] : LG2_GAMMA[3]; }

constexpr int EPS_STRIDE = 132;
DI void epi_scatter(LAS float* scr, const f32x4 (&acc)[8], int lane) {
#pragma unroll
    for (int c = 0; c < 8; ++c)
#pragma unroll
        for (int r = 0; r < 4; ++r) scr[(4 * (lane >> 4) + r) * EPS_STRIDE + 16 * c + (lane & 15)] = acc[c][r];
}
DI void epi_gather(const LAS float* scr, int lane, int p, float (&v)[8]) {
    const LAS float* s = scr + (4 * p + (lane >> 4)) * EPS_STRIDE + 8 * (lane & 15);
    const f32x4 a = *(const LAS f32x4*)s, b = *(const LAS f32x4*)(s + 4);
    v[0] = a[0]; v[1] = a[1]; v[2] = a[2]; v[3] = a[3]; v[4] = b[0]; v[5] = b[1]; v[6] = b[2]; v[7] = b[3];
}
DI void unpack8(const u32x4 w, float (&x)[8]) { x[0] = bflo(w.x); x[1] = bfhi(w.x); x[2] = bflo(w.y); x[3] = bfhi(w.y); x[4] = bflo(w.z); x[5] = bfhi(w.z); x[6] = bflo(w.w); x[7] = bfhi(w.w); }
DI u32x4 pack8(const float (&x)[8]) { u32x4 w; w.x = pk2(x[0], x[1]); w.y = pk2(x[2], x[3]); w.z = pk2(x[4], x[5]); w.w = pk2(x[6], x[7]); return w; }

template <bool GUMAP>
DI void p0_transpose_item(const float* W, int K, int N, bf16_t* WT, const float* gk, LAS float* scr, int item, int lane) {
    const int nblk = N / 64, kb = item / nblk, nb = item % nblk, k0 = 64 * kb, n0 = 64 * nb;
    const float* wp = W + (size_t)(k0 + (lane >> 4)) * N + n0 + 4 * (lane & 15);
    f32x4 v[16];
#pragma unroll
    for (int i = 0; i < 16; ++i) v[i] = *(const f32x4*)(wp + (size_t)(4 * i) * N);
#pragma unroll
    for (int i = 0; i < 16; ++i) { const int k = 4 * i + (lane >> 4); const float g = gk ? gk[k0 + k] : 1.0f; LAS float* d = scr + k * 65 + 4 * (lane & 15);
        d[0] = v[i][0] * g; d[1] = v[i][1] * g; d[2] = v[i][2] * g; d[3] = v[i][3] * g; }
    asm volatile("s_waitcnt lgkmcnt(0)" ::: "memory");
    int d0 = n0;
    if (GUMAP) { d0 = (n0 < FF) ? ((n0 >> 7) * 256 + (n0 & 127)) : (((n0 - FF) >> 7) * 256 + 128 + ((n0 - FF) & 127)); }
    const int c = lane & 7;
#pragma unroll
    for (int j = 0; j < 8; ++j) { const int n = (lane >> 3) + 8 * j; const LAS float* s = scr + (8 * c) * 65 + n;
        u32x4 o; o.x = pk2(s[0 * 65], s[1 * 65]); o.y = pk2(s[2 * 65], s[3 * 65]); o.z = pk2(s[4 * 65], s[5 * 65]); o.w = pk2(s[6 * 65], s[7 * 65]);
        *(u32x4*)(WT + (size_t)(d0 + n) * K + k0 + 8 * c) = o; }
    asm volatile("s_waitcnt lgkmcnt(0)" ::: "memory");
}
DI void p0_prologue(Frame& F) {
    const int tid = opaque_tid(), lane = tid & 63, wave = __builtin_amdgcn_readfirstlane(tid >> 6);
    LAS float* scr = (LAS float*)(F.lds + wave * 16640);
    const int gw = F.bid * 8 + wave, NGW = F.G * 8;
    constexpr int I_IN = (D / 64) * (INW / 64), I_OUT = (D / 64) * (D / 64), I_GU = (D / 64) * (GU / 64), I_DN = (FF / 64) * (D / 64);
    constexpr int I_L = I_IN + I_OUT + I_GU + I_DN, NITEMS = DEPTH * I_L;
    for (int it = gw; it < NITEMS; it += NGW) {
        const int l = it / I_L; int r = it % I_L;
        if (r < I_IN) { p0_transpose_item<false>(F.w_in + (size_t)l * D * INW, D, INW, F.WIN + (size_t)l * INW * D, F.norm1_g + l * D, scr, r, lane); continue; } r -= I_IN;
        if (r < I_OUT) { p0_transpose_item<false>(F.w_out + (size_t)l * D * D, D, D, F.WOUT + (size_t)l * D * D, nullptr, scr, r, lane); continue; } r -= I_OUT;
        if (r < I_GU) { p0_transpose_item<true>(F.w_gu + (size_t)l * D * GU, D, GU, F.WGU + (size_t)l * GU * D, F.norm2_g + l * D, scr, r, lane); continue; } r -= I_GU;
        p0_transpose_item<false>(F.w_dn + (size_t)l * FF * D, FF, D, F.WDN + (size_t)l * D * FF, nullptr, scr, r, lane);
    }
    for (int m = gw; m < MV; m += NGW) {
        const float* xrow = (m < MPR) ? F.xp + (size_t)m * D : F.xs + (size_t)(m - MPR) * D;
        const f32x4* xr = (const f32x4*)xrow + lane; float ss = 0.f; u32x2* o8 = (u32x2*)(F.HB + (size_t)m * D) + lane;
#pragma unroll
        for (int j = 0; j < 8; ++j) { const f32x4 v = xr[64 * j]; ss += (v[0] * v[0] + v[1] * v[1]) + (v[2] * v[2] + v[3] * v[3]); u32x2 w; w.x = pk2(v[0], v[1]); w.y = pk2(v[2], v[3]); o8[64 * j] = w; }
        ss = wave_sum(ss);
        if (m < MPR) { if (lane < 8) F.SSQ1[(size_t)m * 8 + lane] = (lane == 0) ? ss : 0.f; }
        else { F.SSQS1[(size_t)(m - MPR) * 128 + lane] = (lane == 0) ? ss : 0.f; F.SSQS1[(size_t)(m - MPR) * 128 + 64 + lane] = 0.f; }
    }
    const int gt = F.bid * 512 + tid, NGT = F.G * 512;
    for (int i = gt; i < 2049 * 64; i += NGT) { const int pi = i >> 6, f = i & 63; const float pos = (pi < 2048) ? (float)pi : 16384.0f;
        double pw = 1.0, bs = 0.8659643233600653523531691834202299819398;
#pragma unroll
        for (int bit = 0; bit < 6; ++bit) { if ((f >> bit) & 1) pw *= bs; bs *= bs; }
        const float inv = (float)pw; const float ang = pos * inv;
        const double a = (double)ang, kq = __builtin_rint(a * 0.63661977236758134308);
        double r = __builtin_fma(-kq, 1.57079632679489655800e+00, a); r = __builtin_fma(-kq, 6.12323399573676603587e-17, r);
        const double r2 = r * r;
        const double sp = r * (1.0 + r2 * (-1.0 / 6.0 + r2 * (1.0 / 120.0 + r2 * (-1.0 / 5040.0 + r2 * (1.0 / 362880.0 + r2 * (-1.0 / 39916800.0 + r2 * (1.0 / 6227020800.0 + r2 * (-1.0 / 1307674368000.0))))))));
        const double cp = 1.0 + r2 * (-0.5 + r2 * (1.0 / 24.0 + r2 * (-1.0 / 720.0 + r2 * (1.0 / 40320.0 + r2 * (-1.0 / 3628800.0 + r2 * (1.0 / 479001600.0 + r2 * (-1.0 / 87178291200.0 + r2 * (1.0 / 20922789888000.0))))))));
        const int q = (int)((long long)kq & 3);
        const double sn = (q == 0) ? sp : (q == 1) ? cp : (q == 2) ? -sp : -cp, cs = (q == 0) ? cp : (q == 1) ? -sp : (q == 2) ? -cp : sp;
        F.ROPE[2 * i] = (float)cs; F.ROPE[2 * i + 1] = (float)sn; }
    for (int i = gt; i < DEPTH * 4 * 128 * 128; i += NGT) { const int e = i & 127, g4 = (i >> 14) & 3, l = i >> 16;
        F.POOLW[i] = (bf16_t)(pk2(F.pool_w[i] * F.pool_scale[l * 512 + g4 * 128 + e], 0.f) & 0xffffu);
        const int s = i & 127, t = (i >> 7) & 127; F.SGUW[i] = (bf16_t)(pk2(t >= s ? F.sgu_w[i] : 0.f, 0.f) & 0xffffu); }
}

template <class RowMul>
DI void stage_rot(LAS unsigned char* tile, const bf16_t* src, const float* rope_pos0, int tid, RowMul rowmul) {
#pragma unroll
    for (int it = 0; it < 2; ++it) { const int task = tid + 512 * it, row = task >> 3, cp = task & 7;
        const u32x4 lo = *(const u32x4*)(src + (size_t)row * INW + 8 * cp), hi = *(const u32x4*)(src + (size_t)row * INW + 64 + 8 * cp);
        const f32x4* rp = (const f32x4*)(rope_pos0 + (size_t)row * 128 + 16 * cp);
        const f32x4 r0 = rp[0], r1 = rp[1], r2 = rp[2], r3 = rp[3];
        const float cs[8] = {r0[0], r0[2], r1[0], r1[2], r2[0], r2[2], r3[0], r3[2]}, sn[8] = {r0[1], r0[3], r1[1], r1[3], r2[1], r2[3], r3[1], r3[3]};
        float x1[8], x2[8], o1[8], o2[8]; unpack8(lo, x1); unpack8(hi, x2); const float sc = rowmul(row);
#pragma unroll
        for (int i = 0; i < 8; ++i) { o1[i] = (x1[i] * cs[i] - x2[i] * sn[i]) * sc; o2[i] = (x2[i] * cs[i] + x1[i] * sn[i]) * sc; }
        *(LAS u32x4*)(tile + off_b(row, cp)) = pack8(o1); *(LAS u32x4*)(tile + off_b(row, cp + 8)) = pack8(o2); }
}
DI void stage_copy(LAS unsigned char* tile, const bf16_t* src, int pitch, int tid) {
#pragma unroll
    for (int it = 0; it < 4; ++it) { const int task = tid + 512 * it, row = task >> 4, ch = task & 15;
        *(LAS u32x4*)(tile + off_b(row, ch)) = *(const u32x4*)(src + (size_t)row * pitch + 8 * ch); }
}

DI void ret_kv_unit(Frame& F, int b, int h, int n) {
    LAS unsigned char* TK = F.lds; LAS unsigned char* TV = F.lds + 32768;
    const int tid = opaque_tid(), lane = tid & 63, w = __builtin_amdgcn_readfirstlane(tid >> 6); const float lg = lg2_gamma(h);
    __syncthreads();
    const size_t row0 = (size_t)b * SEQ + (size_t)n * 128;
    stage_rot(TK, F.PB + row0 * INW + C_K + h * 128, F.ROPE + (size_t)(n * 128) * 128, tid, [lg](int row) { return 0.08838834764831845f * exp2f((float)(127 - row) * lg); });
    stage_copy(TV, F.PB + row0 * INW + C_V + h * 128, INW, tid);
    __syncthreads();
    f32x4 acc[8];
#pragma unroll
    for (int c = 0; c < 8; ++c) acc[c] = (f32x4){0.f, 0.f, 0.f, 0.f};
#pragma unroll
    for (int ks = 0; ks < 4; ++ks) { const bf16x8 a = lds_trfrag(TK, lane, w, ks);
#pragma unroll
        for (int c = 0; c < 8; ++c) { const bf16x8 bb = lds_trfrag(TV, lane, c, ks); acc[c] = MFMA16(a, bb, acc[c]); } }
    float* kv = F.KV + ((size_t)((b * 4 + h) * NCH + n)) * 16384;
#pragma unroll
    for (int c = 0; c < 8; ++c)
#pragma unroll
        for (int r = 0; r < 4; ++r) kv[(16 * w + 4 * (lane >> 4) + r) * 128 + 16 * c + (lane & 15)] = acc[c][r];
}

DI void ret_out_unit(Frame& F, int l, int b, int h, int n) {
    LAS unsigned char* TQ = F.lds; LAS unsigned char* TK = F.lds + 32768; LAS unsigned char* TV = F.lds + 65536; LAS unsigned char* TS = F.lds + 98304;
    const int tid = opaque_tid(), lane = tid & 63, w = __builtin_amdgcn_readfirstlane(tid >> 6); const float lg = lg2_gamma(h);
    __syncthreads();
    const size_t row0 = (size_t)b * SEQ + (size_t)n * 128;
    const float* rope0 = F.ROPE + (size_t)(n * 128) * 128;
    stage_rot(TQ, F.PB + row0 * INW + C_Q + h * 128, rope0, tid, [](int) { return 1.0f; });
    stage_rot(TK, F.PB + row0 * INW + C_K + h * 128, rope0, tid, [](int) { return 0.08838834764831845f; });
    stage_copy(TV, F.PB + row0 * INW + C_V + h * 128, INW, tid);
    if (n > 0) stage_copy(TS, F.SB + ((size_t)((b * 4 + h) * NCH + n)) * 16384, 128, tid);
    __syncthreads();
    f32x4 acc[8];
#pragma unroll
    for (int c = 0; c < 8; ++c) acc[c] = (f32x4){0.f, 0.f, 0.f, 0.f};
    bf16x8 qf[4];
#pragma unroll
    for (int s = 0; s < 4; ++s) qf[s] = lds_rowfrag(TQ, lane, w, s);
    if (n > 0) {
#pragma unroll
        for (int s = 0; s < 4; ++s)
#pragma unroll
            for (int c = 0; c < 8; ++c) { const bf16x8 bb = lds_trfrag(TS, lane, c, s); acc[c] = MFMA16(qf[s], bb, acc[c]); }
        float f[4];
#pragma unroll
        for (int r = 0; r < 4; ++r) f[r] = exp2f((float)(16 * w + 4 * (lane >> 4) + r + 1) * lg);
#pragma unroll
        for (int c = 0; c < 8; ++c)
#pragma unroll
            for (int r = 0; r < 4; ++r) acc[c][r] *= f[r];
    }
    const int i_loc = 16 * w + (lane & 15);
#pragma unroll
    for (int c = 0; c < 8; ++c) if (c <= w) {
        f32x4 sc = (f32x4){0.f, 0.f, 0.f, 0.f};
#pragma unroll
        for (int s = 0; s < 4; ++s) { const bf16x8 kf = lds_rowfrag(TK, lane, c, s); sc = MFMA16(kf, qf[s], sc); }
        float pv[4];
#pragma unroll
        for (int r = 0; r < 4; ++r) { const int j = 16 * c + 4 * (lane >> 4) + r; const int dd = i_loc - j; pv[r] = dd >= 0 ? sc[r] * exp2f((float)dd * lg) : 0.f; }
        u32x2 o; o.x = pk2(pv[0], pv[1]); o.y = pk2(pv[2], pv[3]);
        *(LAS u32x2*)(TQ + off_b(i_loc, 2 * c + (lane >> 5)) + 8 * ((lane >> 4) & 1)) = o;
    }
    if ((w & 1) == 0) { unsigned zz = 0u; asm volatile("" : "+v"(zz)); u32x2 z; z.x = zz; z.y = zz; *(LAS u32x2*)(TQ + off_b(i_loc, 2 * (w + 1) + (lane >> 5)) + 8 * ((lane >> 4) & 1)) = z; }
#pragma unroll
    for (int ks = 0; ks < 4; ++ks) if (ks <= (w >> 1)) { const bf16x8 a = lds_rowfrag(TQ, lane, w, ks);
#pragma unroll
        for (int c = 0; c < 8; ++c) { const bf16x8 bb = lds_trfrag(TV, lane, c, ks); acc[c] = MFMA16(a, bb, acc[c]); } }
#pragma unroll
    for (int r = 0; r < 4; ++r) { float s = 0.f;
#pragma unroll
        for (int c = 0; c < 8; ++c) s += acc[c][r];
        s += __shfl_xor(s, 1); s += __shfl_xor(s, 2); s += __shfl_xor(s, 4); s += __shfl_xor(s, 8);
        const float mean = s * (1.0f / 128.0f); float q = 0.f;
#pragma unroll
        for (int c = 0; c < 8; ++c) { const float d = acc[c][r] - mean; acc[c][r] = d; q += d * d; }
        q += __shfl_xor(q, 1); q += __shfl_xor(q, 2); q += __shfl_xor(q, 4); q += __shfl_xor(q, 8);
        const float rstd = 1.0f / sqrtf(q * (1.0f / 128.0f) + NORM_EPS);
#pragma unroll
        for (int c = 0; c < 8; ++c) acc[c][r] *= rstd; }
    __syncthreads();
    LAS float* scr = (LAS float*)(F.lds + w * 8448);
    epi_scatter(scr, acc, lane);
    const float* gn = F.ret_norm_g + l * 512 + h * 128 + 8 * (lane & 15);
    const f32x4 g0 = *(const f32x4*)gn, g1 = *(const f32x4*)(gn + 4);
    const float gg[8] = {g0[0], g0[1], g0[2], g0[3], g1[0], g1[1], g1[2], g1[3]};
#pragma unroll
    for (int p = 0; p < 4; ++p) { float v[8]; epi_gather(scr, lane, p, v); const size_t grow = row0 + 16 * w + 4 * p + (lane >> 4);
        float gt[8]; unpack8(*(const u32x4*)(F.PB + grow * INW + C_G + h * 128 + 8 * (lane & 15)), gt);
#pragma unroll
        for (int i = 0; i < 8; ++i) v[i] = v[i] * gg[i] * silu_f(gt[i]);
        *(u32x4*)(F.MIX + grow * D + 1024 + h * 128 + 8 * (lane & 15)) = pack8(v); }
}

DI void pool_unit(Frame& F, int l, int b, int tt, int gi) {
    LAS unsigned char* TA = F.lds; LAS unsigned char* TD = F.lds + 40960; LAS unsigned char* TW = F.lds + 73728;
    const int tid = opaque_tid(), lane = tid & 63, w = __builtin_amdgcn_readfirstlane(tid >> 6);
    __syncthreads();
    for (int task = tid; task < 143 * 16; task += 512) { const int r = task >> 4, ch = task & 15, tseq = tt * 128 - 15 + r;
        u32x4 v = (u32x4){0u, 0u, 0u, 0u};
        if (tseq >= 0) v = *(const u32x4*)(F.PB + ((size_t)b * SEQ + tseq) * INW + C_A + gi * 128 + 8 * ch);
        *(LAS u32x4*)(TA + r * 256 + ch * 16) = v; }
    stage_copy(TW, F.POOLW + (size_t)((l * 4 + gi) * 128) * 128, 128, tid);
    __syncthreads();
    const int win = 2 << gi;
#pragma unroll
    for (int it = 0; it < 4; ++it) { const int task = tid + 512 * it, t = task >> 4, ch = task & 15;
        float s[8], a[8];
        unpack8(*(const LAS u32x4*)(TA + (t + 15) * 256 + ch * 16), a);
#pragma unroll
        for (int i = 0; i < 8; ++i) s[i] = a[i];
        for (int j = 1; j < win; ++j) { float x[8]; unpack8(*(const LAS u32x4*)(TA + (t + 15 - j) * 256 + ch * 16), x);
#pragma unroll
            for (int i = 0; i < 8; ++i) s[i] += x[i]; }
        const int pos = tt * 128 + t; const float inv = 1.0f / (float)(pos + 1 < win ? pos + 1 : win);
        float d[8];
#pragma unroll
        for (int i = 0; i < 8; ++i) d[i] = s[i] * inv - a[i];
        *(LAS u32x4*)(TD + off_b(t, ch)) = pack8(d);
        if (tt == NCH - 1 && t >= 113) { float* o = F.out + O_POOLP + ((size_t)((l * NB + b) * 15 + (t - 113))) * 512 + gi * 128 + 8 * ch;
            *(f32x4*)o = (f32x4){a[0], a[1], a[2], a[3]}; *(f32x4*)(o + 4) = (f32x4){a[4], a[5], a[6], a[7]}; }
    }
    __syncthreads();
    f32x4 acc[8];
#pragma unroll
    for (int c = 0; c < 8; ++c) acc[c] = (f32x4){0.f, 0.f, 0.f, 0.f};
#pragma unroll
    for (int s = 0; s < 4; ++s) { const bf16x8 a = lds_rowfrag(TD, lane, w, s);
#pragma unroll
        for (int c = 0; c < 8; ++c) { const bf16x8 bb = lds_trfrag(TW, lane, c, s); acc[c] = MFMA16(a, bb, acc[c]); } }
    __syncthreads();
    LAS float* scr = (LAS float*)(F.lds + w * 8448);
    epi_scatter(scr, acc, lane);
#pragma unroll
    for (int p = 0; p < 4; ++p) { float v[8]; epi_gather(scr, lane, p, v); const size_t grow = (size_t)b * SEQ + tt * 128 + 16 * w + 4 * p + (lane >> 4);
        *(u32x4*)(F.MIX + grow * D + gi * 128 + 8 * (lane & 15)) = pack8(v); }
}

DI void sgu_unit(Frame& F, int l, int b, int ck, int h) {
    LAS unsigned char* TV = F.lds;
    const int tid = opaque_tid(), lane = tid & 63, w = __builtin_amdgcn_readfirstlane(tid >> 6);
    __syncthreads();
    const size_t row0 = (size_t)b * SEQ + (size_t)ck * 128;
    { const float* gp = F.sgu_norm_g + l * 512 + 8 * lane; const f32x4 g0 = *(const f32x4*)gp, g1 = *(const f32x4*)(gp + 4);
      const float gg[8] = {g0[0], g0[1], g0[2], g0[3], g1[0], g1[1], g1[2], g1[3]};
      for (int it = 0; it < 16; ++it) { const int st = 16 * w + it;
        float x[8]; unpack8(*(const u32x4*)(F.PB + (row0 + st) * INW + C_VV + 8 * lane), x);
        float s = ((x[0] + x[1]) + (x[2] + x[3])) + ((x[4] + x[5]) + (x[6] + x[7]));
        const float mean = wave_sum(s) * (1.0f / 512.0f); float q = 0.f;
#pragma unroll
        for (int i = 0; i < 8; ++i) { x[i] -= mean; q += x[i] * x[i]; }
        const float rstd = 1.0f / sqrtf(wave_sum(q) * (1.0f / 512.0f) + NORM_EPS);
        if ((lane >> 4) == h) {
#pragma unroll
            for (int i = 0; i < 8; ++i) x[i] = x[i] * rstd * gg[i];
            *(LAS u32x4*)(TV + off_b(st, lane & 15)) = pack8(x);
            if (ck == NCH - 1) { float* o = F.out + O_SGUP + ((size_t)((l * NB + b) * 128 + st)) * 512 + 8 * lane;
                *(f32x4*)o = (f32x4){x[0], x[1], x[2], x[3]}; *(f32x4*)(o + 4) = (f32x4){x[4], x[5], x[6], x[7]}; } } } }
    __syncthreads();
    f32x4 acc[8];
#pragma unroll
    for (int c = 0; c < 8; ++c) acc[c] = (f32x4){0.f, 0.f, 0.f, 0.f};
    const bf16_t* wrow = F.SGUW + ((size_t)((l * 4 + h) * 128 + 16 * w + (lane & 15))) * 128 + 8 * (lane >> 4);
#pragma unroll
    for (int ks = 0; ks < 4; ++ks) if (ks <= (w >> 1)) { const bf16x8 a = *(const bf16x8*)(wrow + 32 * ks);
#pragma unroll
        for (int c = 0; c < 8; ++c) { const bf16x8 bb = lds_trfrag(TV, lane, c, ks); acc[c] = MFMA16(a, bb, acc[c]); } }
    __syncthreads();
    LAS float* scr = (LAS float*)(F.lds + w * 8448);
    epi_scatter(scr, acc, lane);
#pragma unroll
    for (int p = 0; p < 4; ++p) { float v[8]; epi_gather(scr, lane, p, v); const int t = 16 * w + 4 * p + (lane >> 4); const size_t grow = row0 + t;
        const float bias = F.sgu_b[(l * 4 + h) * 128 + t];
        float u[8]; unpack8(*(const u32x4*)(F.PB + grow * INW + C_U + h * 128 + 8 * (lane & 15)), u);
#pragma unroll
        for (int i = 0; i < 8; ++i) v[i] = u[i] * (v[i] + bias);
        *(u32x4*)(F.MIX + grow * D + 1536 + h * 128 + 8 * (lane & 15)) = pack8(v); }
}

DI void conv_flat(Frame& F, int l) {
    const float* cw = F.conv_w + l * 3 * 512; const int tid = opaque_tid();
    for (int task = F.bid * 512 + tid; task < MPR * 64; task += F.G * 512) { const int row = task >> 6, ch = task & 63, t = row & (SEQ - 1), b = row >> 11;
        const bf16_t* p = F.PB + (size_t)row * INW + 8 * ch;
        float z[3][8];
#pragma unroll
        for (int k = 0; k < 3; ++k) { const int back = 2 - k;
            if (t - back >= 0) { float cg[8], hh[8]; unpack8(*(const u32x4*)(p - (size_t)back * INW + C_CG), cg); unpack8(*(const u32x4*)(p - (size_t)back * INW + C_HH), hh);
#pragma unroll
                for (int i = 0; i < 8; ++i) z[k][i] = cg[i] * hh[i]; }
            else {
#pragma unroll
                for (int i = 0; i < 8; ++i) z[k][i] = 0.f; } }
        float bg[8], y[8]; unpack8(*(const u32x4*)(p + C_BG), bg);
#pragma unroll
        for (int i = 0; i < 8; ++i) { const int c = 8 * ch + i; y[i] = bg[i] * (z[0][i] * cw[c] + z[1][i] * cw[512 + c] + z[2][i] * cw[1024 + c]); }
        *(u32x4*)(F.MIX + (size_t)row * D + 512 + 8 * ch) = pack8(y);
        if (t >= SEQ - 2) { float* o = F.out + O_CONVP + ((size_t)((l * NB + b) * 2 + (t - (SEQ - 2)))) * 512 + 8 * ch;
            *(f32x4*)o = (f32x4){z[2][0], z[2][1], z[2][2], z[2][3]}; *(f32x4*)(o + 4) = (f32x4){z[2][4], z[2][5], z[2][6], z[2][7]}; }
    }
}

DI void ret_scan_flat(Frame& F, int l) {
    const int tid = opaque_tid();
    for (int task = F.bid * 512 + tid; task < 16 * 4096; task += F.G * 512) { const int bh = task >> 12, e4 = task & 4095, h = bh & 3; const float g = exp2f(128.0f * lg2_gamma(h));
        const float* kvb = F.KV + (size_t)bh * NCH * 16384 + 4 * e4; bf16_t* sb = F.SB + (size_t)bh * NCH * 16384 + 4 * e4;
        f32x4 kv[NCH];
#pragma unroll
        for (int m = 0; m < NCH; ++m) kv[m] = *(const f32x4*)(kvb + (size_t)m * 16384);
        f32x4 st = kv[0];
#pragma unroll
        for (int n = 1; n < NCH; ++n) { u32x2 o; o.x = pk2(st[0], st[1]); o.y = pk2(st[2], st[3]); *(u32x2*)(sb + (size_t)n * 16384) = o; st = st * g + kv[n]; }
        *(f32x4*)(F.out + O_RETP + ((size_t)(l * 16 + bh)) * 16384 + 4 * e4) = st; }
}

DI void sret_unit(Frame& F, int l, int s, int h) {
    LAS float* qf = (LAS float*)F.lds; LAS float* kf = qf + 128; LAS float* vf = qf + 256; LAS float* red = qf + 384;
    const int tid = opaque_tid(), lane = tid & 63; const size_t row = (size_t)MPR + s; const float gam = exp2f(lg2_gamma(h));
    __syncthreads();
    if (tid < 64) { const bf16_t* p = F.PB + row * INW + h * 128; const float* rp = F.ROPE + ((size_t)ROPE_SPOS * 64 + tid) * 2; const float cs = rp[0], sn = rp[1];
        const float q1 = bf2f(p[C_Q + tid]), q2 = bf2f(p[C_Q + 64 + tid]), k1 = bf2f(p[C_K + tid]), k2 = bf2f(p[C_K + 64 + tid]);
        qf[tid] = q1 * cs - q2 * sn; qf[tid + 64] = q2 * cs + q1 * sn;
        kf[tid] = (k1 * cs - k2 * sn) * 0.08838834764831845f; kf[tid + 64] = (k2 * cs + k1 * sn) * 0.08838834764831845f;
        vf[tid] = bf2f(p[C_V + tid]); vf[tid + 64] = bf2f(p[C_V + 64 + tid]); }
    __syncthreads();
    const int dg = tid >> 5, e4 = (tid & 31) * 4;
    const size_t sb = ((size_t)((l * NS + s) * 4 + h)) * 16384;
    const float* s0 = F.st_ret + sb; float* so = F.out + O_RETS + sb;
    const f32x4 vv = *(const LAS f32x4*)(vf + e4); f32x4 o = (f32x4){0.f, 0.f, 0.f, 0.f};
#pragma unroll
    for (int it = 0; it < 8; ++it) { const int d = dg + 16 * it; const f32x4 a = *(const f32x4*)(s0 + d * 128 + e4); const f32x4 sn = a * gam + vv * kf[d];
        *(f32x4*)(so + d * 128 + e4) = sn; o += sn * qf[d]; }
    *(LAS f32x4*)(red + dg * 128 + e4) = o;
    __syncthreads();
    if (tid < 64) { float o0 = 0.f, o1 = 0.f;
#pragma unroll
        for (int g = 0; g < 16; ++g) { o0 += red[g * 128 + lane]; o1 += red[g * 128 + 64 + lane]; }
        const float mean = wave_sum(o0 + o1) * (1.0f / 128.0f); o0 -= mean; o1 -= mean;
        const float rstd = 1.0f / sqrtf(wave_sum(o0 * o0 + o1 * o1) * (1.0f / 128.0f) + NORM_EPS);
        const bf16_t* gp = F.PB + row * INW + C_G + h * 128; const float* gn = F.ret_norm_g + l * 512 + h * 128;
        bf16_t* mo = F.MIX + row * D + 1024 + h * 128;
        mo[lane] = (bf16_t)(pk2(o0 * rstd * gn[lane] * silu_f(bf2f(gp[lane])), 0.f) & 0xffffu);
        mo[lane + 64] = (bf16_t)(pk2(o1 * rstd * gn[lane + 64] * silu_f(bf2f(gp[lane + 64])), 0.f) & 0xffffu); }
}

DI void smisc_unit(Frame& F, int l, int s) {
    LAS float* dl = (LAS float*)F.lds; LAS float* red = dl + 512;
    const int tid = opaque_tid(), lane = tid & 63, w = __builtin_amdgcn_readfirstlane(tid >> 6); const size_t row = (size_t)MPR + s; const bf16_t* p = F.PB + row * INW;
    __syncthreads();
    {
        const int gi = tid >> 7, win = 2 << gi; const float a0 = bf2f(p[C_A + tid]);
        const float* prev = F.st_pool + ((size_t)(l * NS + s) * 15) * 512 + tid; float* po = F.out + O_POOLS + ((size_t)(l * NS + s) * 15) * 512 + tid;
        float ws = a0;
#pragma unroll
        for (int j = 0; j < 15; ++j) { const float pj = prev[(size_t)j * 512]; if (15 - j < win) ws += pj; if (j >= 1) po[(size_t)(j - 1) * 512] = pj; }
        po[(size_t)14 * 512] = a0;
        dl[tid] = ws / (float)win - a0;
    }
    {
        const float z0 = bf2f(p[C_CG + tid]) * bf2f(p[C_HH + tid]); const float* cw = F.conv_w + l * 3 * 512 + tid;
        const float* pc = F.st_conv + ((size_t)(l * NS + s) * 2) * 512 + tid; const float p0 = pc[0], p1 = pc[512];
        const float y = bf2f(p[C_BG + tid]) * (p0 * cw[0] + p1 * cw[512] + z0 * cw[1024]);
        F.MIX[row * D + 512 + tid] = (bf16_t)(pk2(y, 0.f) & 0xffffu);
        float* co = F.out + O_CONVS + ((size_t)(l * NS + s) * 2) * 512 + tid; co[0] = p1; co[512] = z0;
    }
    const float vvx = bf2f(p[C_VV + tid]);
    { const float sm = wave_sum(vvx); if (lane == 0) red[w] = sm; }
    __syncthreads();
    float mean = 0.f;
#pragma unroll
    for (int i = 0; i < 8; ++i) mean += red[i];
    mean *= (1.0f / 512.0f);
    const float dv = vvx - mean;
    { const float sq = wave_sum(dv * dv); if (lane == 0) red[8 + w] = sq; }
    {
        const int gi = tid >> 7, e = tid & 127; const bf16_t* wp = F.POOLW + ((size_t)(l * 4 + gi) * 128) * 128 + e; float y = 0.f;
#pragma unroll 8
        for (int c = 0; c < 128; ++c) y += dl[gi * 128 + c] * bf2f(wp[(size_t)c * 128]);
        F.MIX[row * D + tid] = (bf16_t)(pk2(y, 0.f) & 0xffffu);
    }
    __syncthreads();
    float var = 0.f;
#pragma unroll
    for (int i = 0; i < 8; ++i) var += red[8 + i];
    const float rstd = 1.0f / sqrtf(var * (1.0f / 512.0f) + NORM_EPS);
    const float vn = dv * rstd * F.sgu_norm_g[l * 512 + tid];
    F.out[O_SGUS + (size_t)(l * NS + s) * 512 + tid] = vn;
    const int h = tid >> 7; const float mixed = F.sgu_w[(size_t)(l * 4 + h) * 16384] * vn + F.sgu_b[(l * 4 + h) * 128];
    F.MIX[row * D + 1536 + tid] = (bf16_t)(pk2(bf2f(p[C_U + tid]) * mixed, 0.f) & 0xffffu);
}

DI void skinny_piece(LAS unsigned char* lds, const bf16_t* A, int lda, const bf16_t* Bt, int K, int piece, const float* base, float* Hs, bf16_t* HBs, float* ssqs) {
    const int tid = opaque_tid(), lane = tid & 63, w = __builtin_amdgcn_readfirstlane(tid >> 6);
    const int rb = piece & 3, cb = piece >> 2, t = w & 3, tr = t >> 1, tc = t & 1, kh = w >> 2, r0 = 32 * rb + 16 * tr, c0 = 32 * cb + 16 * tc, kq = K >> 1;
    const bf16_t* ap = A + (size_t)(r0 + (lane & 15)) * lda + kh * kq + 8 * (lane >> 4);
    const bf16_t* bp = Bt + (size_t)(c0 + (lane & 15)) * K + kh * kq + 8 * (lane >> 4);
    f32x4 acc0 = (f32x4){0.f, 0.f, 0.f, 0.f}, acc1 = acc0;
#pragma unroll 4
    for (int k = 0; k < kq; k += 64) {
        const bf16x8 a0 = *(const bf16x8*)(ap + k), b0 = *(const bf16x8*)(bp + k), a1 = *(const bf16x8*)(ap + k + 32), b1 = *(const bf16x8*)(bp + k + 32);
        acc0 = MFMA16(b0, a0, acc0); acc1 = MFMA16(b1, a1, acc1); }
    acc0 += acc1;
    LAS f32x4* xch = (LAS f32x4*)lds;
    __syncthreads();
    if (kh == 1) xch[t * 64 + lane] = acc0;
    __syncthreads();
    if (kh == 0) {
        const int row = r0 + (lane & 15), col = c0 + 4 * (lane >> 4); const size_t off = (size_t)row * D + col;
        const f32x4 h = *(const f32x4*)(base + off) + acc0 + xch[t * 64 + lane];
        *(f32x4*)(Hs + off) = h;
        u32x2 o; o.x = pk2(h[0], h[1]); o.y = pk2(h[2], h[3]); *(u32x2*)(HBs + off) = o;
        float ss = (h[0] * h[0] + h[1] * h[1]) + (h[2] * h[2] + h[3] * h[3]);
        ss += __shfl_xor(ss, 16); ss += __shfl_xor(ss, 32);
        if (lane < 16) ssqs[(size_t)row * 128 + 2 * cb + tc] = ss;
    }
}

DI void final_norm(Frame& F) {
    const int tid = opaque_tid(), lane = tid & 63, wave = __builtin_amdgcn_readfirstlane(tid >> 6);
    const int gw = F.bid * 8 + wave, NGW = F.G * 8;
    for (int m = gw; m < MV; m += NGW) { float rs;
        if (m < MPR) rs = pg8::row_rstd(F.SSQ1, F.SSQS1, m);
        else { const float* p = F.SSQS1 + (size_t)(m - MPR) * 128; rs = 1.0f / sqrtf(wave_sum(p[lane] + p[64 + lane]) * (1.0f / (float)D) + NORM_EPS); }
        const f32x4* hr = (const f32x4*)(F.H + (size_t)m * D) + lane; const f32x4* gr = (const f32x4*)F.final_g + lane;
        f32x4* o = (f32x4*)(F.out + (m < MPR ? O_YP + (size_t)m * D : O_YS + (size_t)(m - MPR) * D)) + lane;
#pragma unroll
        for (int j = 0; j < 8; ++j) o[64 * j] = hr[64 * j] * rs * gr[64 * j]; }
}

constexpr int N_PHASES = 2 + 7 * DEPTH;
__global__ void __launch_bounds__(512, 2) mk_fwd(Args args) {
    extern __shared__ __attribute__((aligned(16))) unsigned char lds[];
    Frame F;
    F.lds = (LAS unsigned char*)lds; F.misc = F.lds + MISC_OFF;
    F.G = gridDim.x; F.bid = blockIdx.x;
    unsigned char* ws = args.ws;
    F.xp = args.in[0]; F.xs = args.in[1]; F.st_pool = args.in[2]; F.st_conv = args.in[3]; F.st_ret = args.in[4]; F.norm1_g = args.in[5]; F.w_in = args.in[6];
    F.pool_w = args.in[7]; F.pool_scale = args.in[8]; F.conv_w = args.in[9]; F.ret_norm_g = args.in[10]; F.sgu_norm_g = args.in[11]; F.sgu_w = args.in[12]; F.sgu_b = args.in[13];
    F.w_out = args.in[14]; F.norm2_g = args.in[15]; F.w_gu = args.in[16]; F.w_dn = args.in[17]; F.final_g = args.in[18]; F.out = args.out;
    F.ROPE = (float*)(ws + WS_ROPE); F.SSQ1 = (float*)(ws + WS_SSQ1); F.SSQ2 = (float*)(ws + WS_SSQ2); F.SSQS1 = (float*)(ws + WS_SSQS1); F.SSQS2 = (float*)(ws + WS_SSQS2); F.H = (float*)(ws + WS_H); F.KV = (float*)(ws + WS_KV);
    F.POOLW = (bf16_t*)(ws + WS_POOLW); F.SGUW = (bf16_t*)(ws + WS_SGUW); F.WIN = (bf16_t*)(ws + WS_WIN); F.WOUT = (bf16_t*)(ws + WS_WOUT); F.WGU = (bf16_t*)(ws + WS_WGU); F.WDN = (bf16_t*)(ws + WS_WDN);
    F.HB = (bf16_t*)(ws + WS_HB); F.PB = (bf16_t*)(ws + WS_PB); F.MIX = (bf16_t*)(ws + WS_MIX); F.ACT = (bf16_t*)(ws + WS_ACT); F.SB = (bf16_t*)(ws + WS_SB);
    for (int u = threadIdx.x; u < (LDS_BYTES - LDSCTL_OFF) / 4; u += 512) ((LAS unsigned*)(F.lds + LDSCTL_OFF))[u] = 0u;
    __syncthreads();
    XcdBarrier bar; bar.bar = (unsigned*)(ws + WS_CTL) + CW_BAR; bar.x = 0; bar.st = nullptr;
    if (MK_N_LAUNCHES == 1) bar = xcd_barrier_post((unsigned*)(ws + WS_CTL) + CW_BAR, (volatile LAS unsigned*)(F.lds + LDSCTL_OFF));
    const int lo = args.ph_lo, hi = args.ph_hi;
#define IN(k) (lo <= (k) && (k) < hi)
#define SEAM(k) do { if (IN(k) && IN((k) + 1)) xcd_barrier(bar); } while (0)

#define REPS(t) ((PROBE_DUP == (t)) ? 2 : 1)
#define REP_BAR(t) do { if (rep + 1 < REPS(t)) xcd_barrier(bar); } while (0)
    float* const DUMH = (float*)(ws + WS_DUMH); bf16_t* const DUMHB = (bf16_t*)(ws + WS_DUMHB); float* const DUMSSQ = (float*)(ws + WS_DUMSSQ);
    if (IN(0)) for (int rep = 0; rep < REPS(0); ++rep) { p0_prologue(F); REP_BAR(0); } SEAM(0);
    for (int l = 0; l < DEPTH; ++l) {
        const int p = 1 + 7 * l;
        if (IN(p)) for (int rep = 0; rep < REPS(1); ++rep) {
            pg8::Gemm g{F.HB, F.WIN + (size_t)l * INW * D, MP, INW, D}; pg8::StaticOrder S; S.init(MP, INW, F.G, opaque_sgpr(F.bid));
            pg8::EpiIn E{F.PB, F.SSQ1, F.SSQS1};
            pg8::gemm_phase<pg8::EpiIn, pg8::StaticOrder, true, true>(F.lds, F.misc, g, S, E);
            REP_BAR(1);
        } SEAM(p);
        if (IN(p + 1)) for (int rep = 0; rep < REPS(2); ++rep) {
            const int NJ = 256 + 512 + 128;
            for (int j = F.bid; j < NJ; j += F.G) {
                if (j < 256) ret_kv_unit(F, j >> 6, (j >> 4) & 3, j & 15);
                else if (j < 768) { const int k = j - 256; sret_unit(F, l, k >> 2, k & 3); }
                else smisc_unit(F, l, j - 768);
            }
            conv_flat(F, l);
            REP_BAR(2);
        } SEAM(p + 1);
        if (IN(p + 2)) for (int rep = 0; rep < REPS(3); ++rep) {
            ret_scan_flat(F, l);
            const int NJ = 512;
            for (int j = F.bid; j < NJ; j += F.G) {
                if (j < 256) pool_unit(F, l, j >> 6, (j >> 2) & 15, j & 3);
                else { const int k = j - 256; sgu_unit(F, l, k >> 6, (k >> 2) & 15, k & 3); }
            }
            __syncthreads();
            REP_BAR(3);
        } SEAM(p + 2);
        if (IN(p + 3)) for (int rep = 0; rep < REPS(4); ++rep) {
            const bool dm = rep + 1 < REPS(4);
            for (int j = F.bid; j < 256; j += F.G) ret_out_unit(F, l, j >> 6, (j >> 4) & 3, j & 15);
            for (int j = F.bid; j < 256; j += F.G)
                skinny_piece(F.lds, F.MIX + (size_t)MPR * D, D, F.WOUT + (size_t)l * D * D, D, j, l == 0 ? F.xs : F.H + (size_t)MPR * D,
                             (dm ? DUMH : F.H) + (size_t)MPR * D, (dm ? DUMHB : F.HB) + (size_t)MPR * D, dm ? DUMSSQ : F.SSQS2);
            __syncthreads();
            REP_BAR(4);
        } SEAM(p + 3);
        if (IN(p + 4)) for (int rep = 0; rep < REPS(5); ++rep) {
            const bool dm = rep + 1 < REPS(5);
            pg8::Gemm g{F.MIX, F.WOUT + (size_t)l * D * D, MPR, D, D}; pg8::StaticOrder S; S.init(MPR, D, F.G, opaque_sgpr(F.bid));
            pg8::EpiRes E{l == 0 ? F.xp : F.H, dm ? DUMH : F.H, dm ? DUMHB : F.HB, dm ? DUMSSQ : F.SSQ2};
            pg8::gemm_phase<pg8::EpiRes, pg8::StaticOrder, true, true>(F.lds, F.misc, g, S, E);
            REP_BAR(5);
        } SEAM(p + 4);
        if (IN(p + 5)) for (int rep = 0; rep < REPS(6); ++rep) {
            pg8::Gemm g{F.HB, F.WGU + (size_t)l * GU * D, MP, GU, D}; pg8::StaticOrder S; S.init(MP, GU, F.G, opaque_sgpr(F.bid));
            pg8::EpiGu E{F.ACT, F.SSQ2, F.SSQS2};
            pg8::gemm_phase<pg8::EpiGu, pg8::StaticOrder, true, true>(F.lds, F.misc, g, S, E);
            REP_BAR(6);
        } SEAM(p + 5);
        if (IN(p + 6)) for (int rep = 0; rep < REPS(7); ++rep) {
            const bool dm = rep + 1 < REPS(7);
            pg8::Gemm g{F.ACT, F.WDN + (size_t)l * D * FF, MPR, D, FF}; pg8::StaticOrder S; S.init(MPR, D, F.G, opaque_sgpr(F.bid));
            pg8::EpiRes E{F.H, dm ? DUMH : F.H, dm ? DUMHB : F.HB, dm ? DUMSSQ : F.SSQ1};
            pg8::gemm_phase<pg8::EpiRes, pg8::StaticOrder, true, true>(F.lds, F.misc, g, S, E);
            for (int j = F.bid; j < 256; j += F.G)
                skinny_piece(F.lds, F.ACT + (size_t)MPR * FF, FF, F.WDN + (size_t)l * D * FF, FF, j, F.H + (size_t)MPR * D, (dm ? DUMH : F.H) + (size_t)MPR * D, (dm ? DUMHB : F.HB) + (size_t)MPR * D, dm ? DUMSSQ : F.SSQS1);
            REP_BAR(7);
        } SEAM(p + 6);
    }
    if (IN(N_PHASES - 1)) for (int rep = 0; rep < REPS(8); ++rep) { final_norm(F); REP_BAR(8); }
#undef REPS
#undef REP_BAR
#undef IN
#undef SEAM
}

extern "C" void kernel_launch(void* const* d_in, const int* in_sizes, int n_in, void* d_out, int out_size, void* d_ws, size_t ws_size, hipStream_t stream) {
    static int grid = 0;
    if (grid == 0) {
        if (n_in != 19 || (size_t)out_size != O_END || ws_size < WS_END) { fprintf(stderr, "kernel_launch: unexpected sizes (n_in %d, out %d, ws %zu)\n", n_in, out_size, ws_size); grid = -1; return; }
        int dev = 0, cus = 0, per_cu = 0;
        if (hipGetDevice(&dev) != hipSuccess || hipDeviceGetAttribute(&cus, hipDeviceAttributeMultiprocessorCount, dev) != hipSuccess) { grid = -1; return; }
        if (hipFuncSetAttribute((const void*)mk_fwd, hipFuncAttributeMaxDynamicSharedMemorySize, LDS_BYTES) != hipSuccess) { fprintf(stderr, "kernel_launch: hipFuncSetAttribute failed\n"); grid = -1; return; }
        if (hipOccupancyMaxActiveBlocksPerMultiprocessor(&per_cu, (const void*)mk_fwd, 512, LDS_BYTES) != hipSuccess || per_cu < 1) { fprintf(stderr, "kernel_launch: occupancy query says %d blocks per CU\n", per_cu); per_cu = 1; }
        (void)hipGetLastError();
        grid = cus;
    }
    if (grid < 0) return;
    (void)hipMemsetAsync((char*)d_ws + WS_CTL, 0, CTL_ZERO_BYTES, stream);
    Args a{};
    for (int i = 0; i < 19; ++i) a.in[i] = (const float*)d_in[i];
    a.out = (float*)d_out; a.ws = (unsigned char*)d_ws;
    if (MK_N_LAUNCHES == 1) { a.ph_lo = 0; a.ph_hi = N_PHASES; a.li = 0; hipLaunchKernelGGL(mk_fwd, dim3(grid), dim3(512), LDS_BYTES, stream, a); }
    else for (int li = 0; li < N_PHASES; ++li) { a.ph_lo = li; a.ph_hi = li + 1; a.li = li; hipLaunchKernelGGL(mk_fwd, dim3(grid), dim3(512), LDS_BYTES, stream, a); }
}
```

```cpp
#include <hip/hip_runtime.h>
#include <cstdio>
#include <cstdint>

#ifndef MK_N_LAUNCHES
#define MK_N_LAUNCHES 1
#endif

#ifndef PROBE_CLK
#define PROBE_CLK 0
#endif
#ifndef PROBE_UNIT
#define PROBE_UNIT 0
#endif
#ifndef PROBE_SEAM
#define PROBE_SEAM (-1)
#endif
#ifndef FILL_MODE
#define FILL_MODE 1
#endif
#ifndef PROBE_XBAR
#define PROBE_XBAR 0
#endif
#ifndef PROBE_VAR
#define PROBE_VAR 0
#endif
#ifndef PROBE_DUP
#define PROBE_DUP (-1)
#endif
#define LAS __attribute__((address_space(3)))
#define GAS __attribute__((address_space(1)))
#define DI __device__ __forceinline__

typedef unsigned short bf16_t;
typedef short bf16x8 __attribute__((ext_vector_type(8)));
typedef short s16x4 __attribute__((ext_vector_type(4)));
typedef float f32x4 __attribute__((ext_vector_type(4)));
typedef float f32x2 __attribute__((ext_vector_type(2)));
typedef unsigned u32x4 __attribute__((ext_vector_type(4)));
typedef unsigned u32x2 __attribute__((ext_vector_type(2)));
typedef __bf16 bf16x2_t __attribute__((ext_vector_type(2)));

constexpr int D = 2048, INW = 5120, FF = 5632, GU = 2 * FF;
constexpr int NB = 4, SEQ = 2048, MPR = NB * SEQ  , NS = 128, MV = MPR + NS  , MP = 8448  ;
constexpr int DEPTH = 2, NCH = SEQ / 128  ;
constexpr int C_A = 0, C_BG = 512, C_CG = 1024, C_HH = 1536, C_Q = 2048, C_K = 2560, C_V = 3072, C_G = 3584, C_U = 4096, C_VV = 4608;
constexpr float NORM_EPS = 1e-6f;
#ifndef WPAD
#define WPAD 0
#endif
constexpr int KPD = D + WPAD, KPF = FF + WPAD;
constexpr int ROPE_SPOS = 2048;
constexpr size_t O_YP = 0, O_YS = 16777216, O_POOLP = 17039360, O_POOLS = 17100800, O_CONVP = 19066880, O_CONVS = 19075072,
                 O_RETP = 19337216, O_RETS = 19861504, O_SGUP = 36638720, O_SGUS = 37163008, O_END = 37294080;

constexpr size_t MiB = 1u << 20;
constexpr size_t WS_CTL = 0, CTL_ZERO_BYTES = 1 * MiB;
constexpr size_t WS_ROPE = 1 * MiB;
constexpr size_t WS_POOLW = 3 * MiB;
constexpr size_t WS_SGUW = 4 * MiB;
constexpr size_t WS_SSQ1 = 5 * MiB, WS_SSQ2 = 6 * MiB;
constexpr size_t WS_SSQS1 = 7 * MiB, WS_SSQS2 = 7 * MiB + 65536;
constexpr size_t WS_WIN = 8 * MiB;
constexpr size_t WS_WOUT = 52 * MiB;
constexpr size_t WS_WGU = 70 * MiB;
constexpr size_t WS_WDN = 162 * MiB;
constexpr size_t WS_H = 208 * MiB;
constexpr size_t WS_HB = 274 * MiB;
constexpr size_t WS_PB = 310 * MiB;
constexpr size_t WS_MIX = 394 * MiB;
constexpr size_t WS_ACT = 430 * MiB;
constexpr size_t WS_KV = 523 * MiB;
constexpr size_t WS_SB = 540 * MiB;
constexpr size_t WS_SPART = 548 * MiB;
constexpr size_t WS_DUMH = 556 * MiB, WS_DUMHB = 622 * MiB, WS_DUMSSQ = 658 * MiB;
constexpr size_t WS_END = 660 * MiB;
static_assert(WS_WIN + (size_t)2 * INW * KPD * 2 <= WS_WOUT && WS_WOUT + (size_t)2 * D * KPD * 2 <= WS_WGU && WS_WGU + (size_t)2 * GU * KPD * 2 <= WS_WDN && WS_WDN + (size_t)2 * D * KPF * 2 <= WS_H, "weight buffers");
constexpr int CW_BAR = 4096;
constexpr int CW_SGATE = 8192;
constexpr int CW_FILL = 8704;

constexpr int RING_BYTES = 131072;
constexpr int MISC_OFF = RING_BYTES;
constexpr int LDSCTL_OFF = MISC_OFF + 4096;
constexpr int LDS_BYTES = 147456;

DI float bf2f(unsigned short b) { return __uint_as_float(((unsigned)b) << 16); }
DI float bflo(unsigned w) { return __uint_as_float(w << 16); }
DI float bfhi(unsigned w) { return __uint_as_float(w & 0xffff0000u); }
DI unsigned pk2(float lo, float hi) { f32x2 v = {lo, hi}; bf16x2_t b = __builtin_convertvector(v, bf16x2_t); return __builtin_bit_cast(unsigned, b); }
DI float wave_sum(float v) {
#pragma unroll
    for (int o = 1; o < 64; o <<= 1) v += __shfl_xor(v, o);
    return v;
}
DI float silu_f(float g) { return g * __builtin_amdgcn_rcpf(1.0f + __builtin_amdgcn_exp2f(g * -1.4426950408889634f)); }
DI float silu_fast(float g) { return silu_f(g); }
DI int opaque_sgpr(int v) { asm volatile("" : "+s"(v)); return v; }
DI int opaque_tid() { int t = threadIdx.x; asm volatile("" : "+v"(t)); return t; }

namespace pg8 {
constexpr int BM = 256, BK = 64, HALF = 128, HTB = HALF * BK * 2  , STAGE_BYTES = 8 * HTB, NXCD = 8, WGM = 8;
#ifndef PG8_LINE128
#define PG8_LINE128 true
#endif
constexpr bool LINE128 = PG8_LINE128;
__host__ __device__ __forceinline__ int lds_byte(int r, int c) { const int st = (r >> 4) * 2 + (c >> 5), rr = r & 15, cc = c & 31, ob = rr * 64 + cc * 2; return st * 1024 + (ob ^ (((ob >> 9) & 1) << 5)); }
__host__ __device__ __forceinline__ void stage_rc(int b, int& R, int& C) { const int st = b / 1024, sb = b % 1024, swz = sb ^ (((sb >> 9) & 1) << 5); R = (st >> 1) * 16 + swz / 64; C = (st & 1) * 32 + (swz % 64) / 2; }
__host__ __device__ __forceinline__ int perm32(int rho) { const int n = rho >> 4, i = rho & 15; return 8 * (i >> 2) + 4 * n + (i & 3); }

struct Unit { int pm, pn, hh; };
struct Gemm { const bf16_t* A; const bf16_t* Bt; int M, N, K, lda, ldb; };

struct StaticOrder {
    int nM, nN, nwg, G, c;
    __host__ __device__ void init(int M, int N, int G_, int c_) { nM = M / BM; nN = N / BM; nwg = nM * nN; G = G_; c = c_; }
    __host__ __device__ bool next(int i, Unit& u) const {
        const long L = (long)i * G + c; if (L >= nwg) return false;
        int wgid = (int)L; { const int q = nwg / NXCD, r = nwg % NXCD, xcd = wgid % NXCD, off = wgid / NXCD; wgid = (xcd < r ? xcd * (q + 1) : r * (q + 1) + (xcd - r) * q) + off; }
        const int nig = WGM * nN, gid = wgid / nig, fm = gid * WGM, gsz = (nM - fm) < WGM ? (nM - fm) : WGM;
        u.pm = fm + ((wgid % nig) % gsz); u.pn = (wgid % nig) / gsz; u.hh = hh_all; return true;
    }
    __device__ __forceinline__ void a_ready(const Unit&) const {}
    __device__ __forceinline__ void done(const Unit&) const {}
    int hh_all = -1;
};

struct GatedOrder : StaticOrder {
    unsigned* cnt; unsigned need;
    __device__ __forceinline__ void a_ready(const Unit& u) const {
        if (u.pm * BM >= MPR) {
            if (opaque_tid() < 64) { unsigned sp = 0;
                while ((unsigned)__builtin_amdgcn_readfirstlane(__hip_atomic_load(cnt, __ATOMIC_RELAXED, __HIP_MEMORY_SCOPE_AGENT)) < need) { __builtin_amdgcn_s_sleep(2); if (++sp > (1u << 22)) break; }
                __builtin_amdgcn_fence(__ATOMIC_ACQUIRE, "agent");
                asm volatile("s_waitcnt vmcnt(0)" ::: "memory"); }
            asm volatile("" ::: "memory"); __builtin_amdgcn_s_barrier(); asm volatile("" ::: "memory");
        }
    }
};

DI float row_rstd(const float* ssq, const float* ssqs, int row) {
    float ss;
    if (row < MPR) { const f32x4 s0 = *(const f32x4*)(ssq + (size_t)row * 8), s1 = *(const f32x4*)(ssq + (size_t)row * 8 + 4);
        ss = ((s0[0] + s0[1]) + (s0[2] + s0[3])) + ((s1[0] + s1[1]) + (s1[2] + s1[3])); }
    else { const f32x4* p = (const f32x4*)(ssqs + (size_t)(row - MPR) * 128); f32x4 a = p[0];
#pragma unroll
        for (int i = 1; i < 32; ++i) a += p[i];
        ss = (a[0] + a[1]) + (a[2] + a[3]); }
    return __builtin_amdgcn_rsqf(ss * (1.0f / (float)D) + NORM_EPS);
}
DI void tile_rstd(const float* ssq, const float* ssqs, int pm, int row0, float (&rs)[2][4], LAS unsigned char* misc, int tid) {
    if (pm * BM < MPR) {
        f32x4 a[2][4], b[2][4];
#pragma unroll
        for (int ai = 0; ai < 2; ++ai)
#pragma unroll
            for (int m = 0; m < 4; ++m) { const float* p = ssq + (size_t)(row0 + ai * HALF + m * 16) * 8; a[ai][m] = *(const f32x4*)p; b[ai][m] = *(const f32x4*)(p + 4); }
#pragma unroll
        for (int ai = 0; ai < 2; ++ai)
#pragma unroll
            for (int m = 0; m < 4; ++m) { const f32x4 t = a[ai][m] + b[ai][m]; rs[ai][m] = __builtin_amdgcn_rsqf(((t[0] + t[1]) + (t[2] + t[3])) * (1.0f / (float)D) + NORM_EPS); }
    } else {
        LAS float* tab = (LAS float*)misc;
        { const f32x4* p = (const f32x4*)(ssqs + (size_t)(tid >> 2) * 128 + (tid & 3) * 32); f32x4 t = p[0];
#pragma unroll
          for (int i = 1; i < 8; ++i) t += p[i];
          float ss = (t[0] + t[1]) + (t[2] + t[3]); ss += __shfl_xor(ss, 1); ss += __shfl_xor(ss, 2);
          if ((tid & 3) == 0) tab[tid >> 2] = __builtin_amdgcn_rsqf(ss * (1.0f / (float)D) + NORM_EPS); }
        asm volatile("s_waitcnt lgkmcnt(0)" ::: "memory"); __builtin_amdgcn_s_barrier(); asm volatile("" ::: "memory");
#pragma unroll
        for (int m = 0; m < 4; ++m) { const int r = row0 + m * 16 - MPR; rs[0][m] = (r < NS) ? tab[r] : 0.f; rs[1][m] = 0.f; }
    }
}
struct EpiIn {
    static constexpr bool PERM = true;
    bf16_t* P; const float* ssq; const float* ssqs;
    DI void operator()(const f32x4 (&acc)[2][2][4][2], const Unit& u, int wr, int wc, int fr, int fq, LAS unsigned char* misc, int tid) const {
        tid = opaque_tid(); fr = tid & 15; fq = (tid >> 4) & 3;
        const int row0 = u.pm * BM + wr * 64 + fr, col0 = u.pn * BM + wc * 32 + 8 * fq;
        float rsv[2][4]; tile_rstd(ssq, ssqs, u.pm, row0, rsv, misc, tid);
#pragma unroll
        for (int ai = 0; ai < 2; ++ai)
#pragma unroll
            for (int m = 0; m < 4; ++m) { const int row = row0 + ai * HALF + m * 16;
                if (row < MV) { const float rs = rsv[ai][m]; bf16_t* rowp = P + (size_t)row * INW + col0;
#pragma unroll
                    for (int bj = 0; bj < 2; ++bj) { const f32x4 v0 = acc[ai][bj][m][0] * rs, v1 = acc[ai][bj][m][1] * rs;
                        u32x4 w; w.x = pk2(v0[0], v0[1]); w.y = pk2(v0[2], v0[3]); w.z = pk2(v1[0], v1[1]); w.w = pk2(v1[2], v1[3]);
                        *(u32x4*)(rowp + bj * HALF) = w; } } }
    }
};
template <int VAR>
struct EpiGuT {
    static constexpr bool PERM = true;
    bf16_t* ACT; const float* ssq; const float* ssqs;
    DI void operator()(const f32x4 (&acc)[2][2][4][2], const Unit& u, int wr, int wc, int fr, int fq, LAS unsigned char* misc, int tid) const {
        tid = opaque_tid(); fr = tid & 15; fq = (tid >> 4) & 3;
        const int row0 = u.pm * BM + wr * 64 + fr, col0 = u.pn * HALF + wc * 32 + 8 * fq;
        float rsv[2][4]; tile_rstd(ssq, ssqs, u.pm, row0, rsv, misc, tid);
#pragma unroll
        for (int ai = 0; ai < 2; ++ai)
#pragma unroll
            for (int m = 0; m < 4; ++m) { const int row = row0 + ai * HALF + m * 16;
                if (row < MV) { const float rs = rsv[ai][m];
                    float o[8];
#pragma unroll
                    for (int n = 0; n < 2; ++n)
#pragma unroll
                        for (int j = 0; j < 4; ++j) { const float g = acc[ai][0][m][n][j] * rs, up = acc[ai][1][m][n][j] * rs;
                            o[n * 4 + j] = (VAR == 3) ? g + up : (VAR == 4) ? silu_fast(g) * up : silu_f(g) * up; }
                    u32x4 w; w.x = pk2(o[0], o[1]); w.y = pk2(o[2], o[3]); w.z = pk2(o[4], o[5]); w.w = pk2(o[6], o[7]);
                    if (VAR == 2) asm volatile("" :: "v"(w)); else *(u32x4*)(ACT + (size_t)row * FF + col0) = w; } }
    }
};
typedef EpiGuT<0> EpiGu;
struct EpiNull {
    static constexpr bool PERM = true;
    DI void operator()(const f32x4 (&acc)[2][2][4][2], const Unit&, int, int, int, int, LAS unsigned char*, int) const {
#pragma unroll
        for (int ai = 0; ai < 2; ++ai)
#pragma unroll
            for (int bj = 0; bj < 2; ++bj)
#pragma unroll
                for (int m = 0; m < 4; ++m)
#pragma unroll
                    for (int n = 0; n < 2; ++n) asm volatile("" :: "v"(acc[ai][bj][m][n]));
    }
};
template <bool BASE_BF16, bool OUT_F32>
struct EpiRes {
    static constexpr bool PERM = true;
    const float* base_f; const bf16_t* base_b;
    float* H; bf16_t* HB; float* ssq_out;
    DI void operator()(const f32x4 (&acc)[2][2][4][2], const Unit& u, int wr, int wc, int fr, int fq, LAS unsigned char* misc, int tid) const {
        tid = opaque_tid(); fr = tid & 15; fq = (tid >> 4) & 3;
        LAS float* part = (LAS float*)misc;
        const int col0 = u.pn * BM + wc * 32 + 8 * fq;
#pragma unroll
        for (int ai = 0; ai < 2; ++ai)
#pragma unroll
          for (int mh = 0; mh < 2; ++mh) {
            f32x4 bb[2][2][2];
#pragma unroll
            for (int mm = 0; mm < 2; ++mm) { const size_t off = (size_t)(u.pm * BM + ai * HALF + wr * 64 + (2 * mh + mm) * 16 + fr) * D + col0;
#pragma unroll
                for (int bj = 0; bj < 2; ++bj) {
                    if (BASE_BF16) { const u32x4 w = *(const u32x4*)(base_b + off + bj * HALF);
                        bb[mm][bj][0] = (f32x4){bflo(w.x), bfhi(w.x), bflo(w.y), bfhi(w.y)}; bb[mm][bj][1] = (f32x4){bflo(w.z), bfhi(w.z), bflo(w.w), bfhi(w.w)}; }
                    else { bb[mm][bj][0] = *(const f32x4*)(base_f + off + bj * HALF); bb[mm][bj][1] = *(const f32x4*)(base_f + off + bj * HALF + 4); } } }
#pragma unroll
            for (int mm = 0; mm < 2; ++mm) { const int m = 2 * mh + mm; const int rl = ai * HALF + wr * 64 + m * 16 + fr, row = u.pm * BM + rl; float ss = 0.f;
                { const size_t off = (size_t)row * D + col0;
#pragma unroll
                    for (int bj = 0; bj < 2; ++bj) { const f32x4 b0 = bb[mm][bj][0], b1 = bb[mm][bj][1];
                        const f32x4 h0 = b0 + acc[ai][bj][m][0], h1 = b1 + acc[ai][bj][m][1];
                        if (OUT_F32) { *(f32x4*)(H + off + bj * HALF) = h0; *(f32x4*)(H + off + bj * HALF + 4) = h1; }
                        else { u32x4 w; w.x = pk2(h0[0], h0[1]); w.y = pk2(h0[2], h0[3]); w.z = pk2(h1[0], h1[1]); w.w = pk2(h1[2], h1[3]);
                            *(u32x4*)(HB + off + bj * HALF) = w; }
                        ss += ((h0[0] * h0[0] + h0[1] * h0[1]) + (h0[2] * h0[2] + h0[3] * h0[3])) + ((h1[0] * h1[0] + h1[1] * h1[1]) + (h1[2] * h1[2] + h1[3] * h1[3])); } }
                ss += __shfl_xor(ss, 16); ss += __shfl_xor(ss, 32);
                if (fq == 0) part[rl * 4 + wc] = ss; } }
        asm volatile("s_waitcnt lgkmcnt(0)" ::: "memory"); __builtin_amdgcn_s_barrier(); asm volatile("" ::: "memory");
        float* so = ssq_out; asm volatile("" : "+v"(so));
        if (tid < 256) { const int row = u.pm * BM + tid; const LAS f32x4* p4 = (const LAS f32x4*)(part + tid * 4); const f32x4 p = *p4;
            __hip_atomic_store(so + (size_t)row * 8 + u.pn, (p[0] + p[1]) + (p[2] + p[3]), __ATOMIC_RELAXED, __HIP_MEMORY_SCOPE_AGENT); }
    }
};

template <class Epi, class Sched, bool ALIGN_EPI, bool SP2>
__device__ __forceinline__ void gemm_phase(LAS unsigned char* lds, LAS unsigned char* misc, const Gemm g, const Sched& S, const Epi& E) {
    const int tid = opaque_tid(), wid = __builtin_amdgcn_readfirstlane(tid >> 6), lane = tid & 63, wr = wid >> 2, wc = wid & 3, fr = lane & 15, fq = lane >> 4;
    const int K = g.K, nt = K / BK;
    unsigned voffA[2], voffB[2];
#pragma unroll
    for (int i = 0; i < 2; ++i) { int R, C; const int Bb = tid * 16 + i * 8192;
        if (LINE128) { R = Bb >> 7; C = ((((Bb >> 4) & 7) ^ (R & 7)) << 3); } else stage_rc(Bb, R, C);
        const int Rb = Epi::PERM ? ((R & ~31) + perm32(R & 31)) : R;
        voffA[i] = (unsigned)(R * g.lda + C) * 2u; voffB[i] = (unsigned)(Rb * g.ldb + C) * 2u; }
    const size_t kstep = (size_t)(BK * 2);
    const size_t hstep = (size_t)HALF * g.lda * 2, hstepB = (size_t)HALF * g.ldb * 2;
    const size_t tstep = 2 * hstep, tstepB = 2 * hstepB;
    const unsigned ldsw = (unsigned)wid * 1024u;
    int aoffk[2], boffk[2];
#pragma unroll
    for (int k = 0; k < 2; ++k) {
        if (LINE128) { aoffk[k] = (wr * 64 + fr) * 128 + ((((4 * k + fq) ^ (fr & 7))) << 4); boffk[k] = (wc * 32 + fr) * 128 + ((((4 * k + fq) ^ (fr & 7))) << 4); }
        else { aoffk[k] = lds_byte(wr * 64 + fr, fq * 8) + k * 1024; boffk[k] = lds_byte(wc * 32 + fr, fq * 8) + k * 1024; } }
#define PG8_SA(b, h) (((b) * 2 + (h)) * HTB)
#define PG8_SB(b, h) ((4 + (b) * 2 + (h)) * HTB)
#define PG8_STAGE(bufoff, gbase, voff) do { _Pragma("unroll") for (int _i = 0; _i < 2; ++_i) \
        __builtin_amdgcn_global_load_lds((const unsigned*)((const char*)(gbase) + (voff)[_i]), (LAS unsigned*)(lds + (bufoff) + ldsw + _i * 8192), 16, 0, 0); } while (0)
#define PG8_LDA(dst, b, h) do { _Pragma("unroll") for (int m = 0; m < 4; ++m) _Pragma("unroll") for (int k = 0; k < 2; ++k) dst[m][k] = *(const LAS bf16x8*)(lds + PG8_SA(b, h) + aoffk[k] + m * 2048); } while (0)
#define PG8_LDB(dst, b, h) do { _Pragma("unroll") for (int n = 0; n < 2; ++n) _Pragma("unroll") for (int k = 0; k < 2; ++k) dst[n][k] = *(const LAS bf16x8*)(lds + PG8_SB(b, h) + boffk[k] + n * 2048); } while (0)
#define PG8_MMA(ai, bj, At, Bt) do { __builtin_amdgcn_s_setprio(1); _Pragma("unroll") for (int m = 0; m < 4; ++m) _Pragma("unroll") for (int n = 0; n < 2; ++n) _Pragma("unroll") for (int k = 0; k < 2; ++k) \
        acc[ai][bj][m][n] = __builtin_amdgcn_mfma_f32_16x16x32_bf16(Bt[n][k], At[m][k], acc[ai][bj][m][n], 0, 0, 0); __builtin_amdgcn_s_setprio(0); } while (0)
#define PG8_WAIT_V(n) asm volatile("s_waitcnt vmcnt(" #n ")" ::: "memory")
#define PG8_WAIT_L(n) asm volatile("s_waitcnt lgkmcnt(" #n ")" ::: "memory")
#define PG8_BAR __builtin_amdgcn_s_barrier()
#define PG8_SCHED __builtin_amdgcn_sched_barrier(0)
    Unit cur, nxt; int ui = 0;
    if (!S.next(0, cur)) return;
    f32x4 acc[2][2][4][2];
#pragma unroll
    for (int a = 0; a < 2; ++a)
#pragma unroll
        for (int b = 0; b < 2; ++b)
#pragma unroll
            for (int m = 0; m < 4; ++m)
#pragma unroll
                for (int n = 0; n < 2; ++n) acc[a][b][m][n] = (f32x4){0.f, 0.f, 0.f, 0.f};
    bf16x8 At[4][2], B0[2][2], B1[2][2];
    const char* cA = (const char*)g.A + (size_t)cur.pm * tstep; const char* cB = (const char*)g.Bt + (size_t)cur.pn * tstepB;
    S.a_ready(cur);
    if constexpr (SP2) {
        PG8_STAGE(PG8_SB(0, 0), cB, voffB); PG8_STAGE(PG8_SB(0, 1), cB + hstepB, voffB); PG8_STAGE(PG8_SA(0, 0), cA, voffA); PG8_STAGE(PG8_SA(0, 1), cA + hstep, voffA);
        if (wr == 1) PG8_BAR;
        PG8_WAIT_V(2); PG8_BAR;
        PG8_STAGE(PG8_SB(1, 0), cB + kstep, voffB); PG8_STAGE(PG8_SA(1, 0), cA + kstep, voffA); PG8_STAGE(PG8_SB(1, 1), cB + hstepB + kstep, voffB);
        PG8_WAIT_V(6); PG8_BAR;
    } else {
        PG8_STAGE(PG8_SB(0, 0), cB, voffB); PG8_STAGE(PG8_SA(0, 0), cA, voffA); PG8_STAGE(PG8_SB(0, 1), cB + hstepB, voffB); PG8_STAGE(PG8_SA(0, 1), cA + hstep, voffA);
        if (wr == 1) PG8_BAR;
        PG8_WAIT_V(4); PG8_BAR;
        PG8_STAGE(PG8_SB(1, 0), cB + kstep, voffB); PG8_STAGE(PG8_SA(1, 0), cA + kstep, voffA); PG8_STAGE(PG8_SB(1, 1), cB + hstepB + kstep, voffB);
        PG8_WAIT_V(6); PG8_BAR;
    }
    for (;;) {
        const bool has_next = S.next(ui + 1, nxt);
        const char* nA = has_next ? (const char*)g.A + (size_t)nxt.pm * tstep : cA; const char* nB = has_next ? (const char*)g.Bt + (size_t)nxt.pn * tstepB : cB;
        for (int t = 0; t < nt; t += 2) {
            const bool last = (t == nt - 2);
            const char* a1 = cA + (size_t)(t + 1) * kstep;
            const char* a2 = last ? nA : cA + (size_t)(t + 2) * kstep; const char* b2 = last ? nB : cB + (size_t)(t + 2) * kstep;
            const char* a3 = a2 + kstep; const char* b3 = b2 + kstep;
            if (last && has_next) S.a_ready(nxt);
            if constexpr (SP2) {
            const bool chalf = (PROBE_DUP >= 0) && cur.hh >= 0;
            PG8_LDB(B0, 0, 0); PG8_LDB(B1, 0, 1); PG8_SCHED; PG8_LDA(At, 0, 0); PG8_STAGE(PG8_SA(1, 1), a1 + hstep, voffA);
            PG8_WAIT_V(8); PG8_WAIT_L(0); PG8_BAR; PG8_MMA(0, 0, At, B0); PG8_MMA(0, 1, At, B1); PG8_BAR; PG8_SCHED;
            if (!chalf) PG8_LDA(At, 0, 1);
            PG8_STAGE(PG8_SB(0, 0), b2, voffB); PG8_STAGE(PG8_SB(0, 1), b2 + hstepB, voffB); PG8_STAGE(PG8_SA(0, 0), a2, voffA);
            PG8_WAIT_V(8); PG8_WAIT_L(0); PG8_BAR; if (!chalf) { PG8_MMA(1, 0, At, B0); PG8_MMA(1, 1, At, B1); } PG8_BAR; PG8_SCHED;
            PG8_LDB(B0, 1, 0); PG8_LDB(B1, 1, 1); PG8_SCHED; PG8_LDA(At, 1, 0); PG8_STAGE(PG8_SA(0, 1), a2 + hstep, voffA);
            PG8_WAIT_V(8); PG8_WAIT_L(0); PG8_BAR; PG8_MMA(0, 0, At, B0); PG8_MMA(0, 1, At, B1); PG8_BAR; PG8_SCHED;
            if (!chalf) PG8_LDA(At, 1, 1);
            PG8_STAGE(PG8_SB(1, 0), b3, voffB); PG8_STAGE(PG8_SB(1, 1), b3 + hstepB, voffB); PG8_STAGE(PG8_SA(1, 0), a3, voffA);
            PG8_WAIT_V(8); PG8_WAIT_L(0); PG8_BAR; if (!chalf) { PG8_MMA(1, 0, At, B0); PG8_MMA(1, 1, At, B1); } PG8_BAR; PG8_SCHED;
            } else {
            PG8_LDB(B0, 0, 0); PG8_SCHED; PG8_LDA(At, 0, 0); PG8_STAGE(PG8_SA(1, 1), a1 + hstep, voffA);
            PG8_WAIT_L(8); PG8_BAR; PG8_WAIT_L(0); PG8_MMA(0, 0, At, B0); PG8_BAR; PG8_SCHED;
            PG8_LDB(B1, 0, 1); PG8_STAGE(PG8_SB(0, 0), b2, voffB);
            PG8_BAR; PG8_WAIT_L(0); PG8_MMA(0, 1, At, B1); PG8_BAR;
            PG8_LDA(At, 0, 1); PG8_STAGE(PG8_SA(0, 0), a2, voffA);
            PG8_BAR; PG8_WAIT_L(0); PG8_MMA(1, 0, At, B0); PG8_BAR; PG8_SCHED;
            PG8_STAGE(PG8_SB(0, 1), b2 + hstepB, voffB);
            PG8_WAIT_V(6); PG8_BAR; PG8_MMA(1, 1, At, B1); PG8_BAR;
            PG8_LDB(B0, 1, 0); PG8_SCHED; PG8_LDA(At, 1, 0); PG8_STAGE(PG8_SA(0, 1), a2 + hstep, voffA);
            PG8_WAIT_L(8); PG8_BAR; PG8_WAIT_L(0); PG8_MMA(0, 0, At, B0); PG8_BAR; PG8_SCHED;
            PG8_LDB(B1, 1, 1); PG8_STAGE(PG8_SB(1, 0), b3, voffB);
            PG8_BAR; PG8_WAIT_L(0); PG8_MMA(0, 1, At, B1); PG8_BAR;
            PG8_LDA(At, 1, 1); PG8_STAGE(PG8_SA(1, 0), a3, voffA);
            PG8_BAR; PG8_WAIT_L(0); PG8_MMA(1, 0, At, B0); PG8_BAR; PG8_SCHED;
            PG8_STAGE(PG8_SB(1, 1), b3 + hstepB, voffB);
            PG8_WAIT_V(6); PG8_BAR; PG8_MMA(1, 1, At, B1); PG8_BAR;
            }
        }
        if constexpr (ALIGN_EPI) { if (wr == 0) PG8_BAR; }
        E(acc, cur, wr, wc, 0, 0, misc, 0); S.done(cur);
        if (!has_next) break;
#pragma unroll
        for (int a = 0; a < 2; ++a)
#pragma unroll
            for (int b = 0; b < 2; ++b)
#pragma unroll
                for (int m = 0; m < 4; ++m)
#pragma unroll
                    for (int n = 0; n < 2; ++n) acc[a][b][m][n] = (f32x4){0.f, 0.f, 0.f, 0.f};
        cur = nxt; cA = nA; cB = nB; ++ui;
        if constexpr (ALIGN_EPI) { if (wr == 1) PG8_BAR; }
    }
    PG8_WAIT_V(0);
    if constexpr (!ALIGN_EPI) { if (wr == 0) PG8_BAR; }
    PG8_BAR;
#undef PG8_SA
#undef PG8_SB
#undef PG8_STAGE
#undef PG8_LDA
#undef PG8_LDB
#undef PG8_MMA
#undef PG8_WAIT_V
#undef PG8_WAIT_L
#undef PG8_BAR
#undef PG8_SCHED
}
}

#define XB_TMO      128
#define XB_XCNT(j)  (256  + 64 * (j))
#define XB_XSUB(j)  (1280 + 64 * (j))
#define XB_XGEN(j)  (2304 + 64 * (j))
#define XB_TOP      3328
#define XB_TOPGEN   3392
#define XCD_BAR_WORDS 3456
#define XB_SPIN_CAP (1u << 18)

DI unsigned xb_ld(unsigned* p)              { return __hip_atomic_load(p, __ATOMIC_RELAXED, __HIP_MEMORY_SCOPE_AGENT); }
DI unsigned xb_add(unsigned* p, unsigned v) { return __hip_atomic_fetch_add(p, v, __ATOMIC_RELAXED, __HIP_MEMORY_SCOPE_AGENT); }
DI unsigned xb_xcc_id() { return (unsigned)__builtin_amdgcn_s_getreg((3 << 11) | 20) & 0xFu; }
#define XB_SPIN(cond, bar) do { unsigned _sp = 0; while (cond) { __builtin_amdgcn_s_sleep(1); \
    if ((++_sp & 255u) == 0u) { if (xb_ld(&(bar)[XB_TMO])) break; if (_sp > XB_SPIN_CAP) { atomicAdd(&(bar)[XB_TMO], 1u); break; } } } } while (0)

struct XcdBarrier { unsigned* bar; unsigned x; volatile LAS unsigned* st; };

DI XcdBarrier xcd_barrier_post(unsigned* bar, volatile LAS unsigned* st) {
    XcdBarrier b; b.bar = bar; b.x = xb_xcc_id(); b.st = st;
    if (threadIdx.x == 0) (void)xb_add(&bar[XB_XCNT(b.x)], 1u);
    return b;
}
DI void xcd_barrier_complete(unsigned* bar, unsigned x, unsigned& nloc, unsigned& nx) {
    const unsigned G = gridDim.x * gridDim.y * gridDim.z;
    unsigned sum, cnt, mine, sp = 0u;
    for (;;) {
        sum = 0u; cnt = 0u; mine = 0u;
#pragma unroll
        for (unsigned j = 0; j < 16; ++j) { const unsigned c = xb_ld(&bar[XB_XCNT(j)]); sum += c; cnt += (c > 0u) ? 1u : 0u; mine = (j == x) ? c : mine; }
        if (sum == G) break;
        __builtin_amdgcn_s_sleep(1);
        if ((++sp & 255u) == 0u) { if (xb_ld(&bar[XB_TMO])) break; if (sp > XB_SPIN_CAP) { atomicAdd(&bar[XB_TMO], 1u); break; } }
    }
    nloc = mine > 0u ? mine : 1u; nx = cnt > 0u ? cnt : 1u;
}
DI void xcd_barrier(const XcdBarrier& b) {
    asm volatile("s_waitcnt vmcnt(0)" ::: "memory");
    __syncthreads();
    if (threadIdx.x == 0) {
        unsigned* bar = b.bar; asm volatile("" : "+s"(bar));
        __builtin_amdgcn_s_waitcnt(0);
        unsigned nloc = b.st[0], nx = b.st[1];
        if (nloc == 0u) { xcd_barrier_complete(bar, b.x, nloc, nx); b.st[0] = nloc; b.st[1] = nx; }
        const unsigned old = xb_add(&bar[XB_XSUB(b.x)], 1u);
        const unsigned gen = old / nloc;
        if (old + 1u == (gen + 1u) * nloc) {
            __builtin_amdgcn_fence(__ATOMIC_RELEASE, "agent");
            asm volatile("s_waitcnt vmcnt(0)" ::: "memory");
            const unsigned og = xb_add(&bar[XB_TOP], 1u);
            const unsigned tg = og / nx;
            if (og + 1u == (tg + 1u) * nx) xb_add(&bar[XB_TOPGEN], 1u);
            else XB_SPIN(xb_ld(&bar[XB_TOPGEN]) == tg, bar);
            __builtin_amdgcn_fence(__ATOMIC_ACQUIRE, "agent");
            xb_add(&bar[XB_XGEN(b.x)], 1u);
            asm volatile("s_waitcnt vmcnt(0)" ::: "memory");
        } else {
            XB_SPIN(xb_ld(&bar[XB_XGEN(b.x)]) == gen, bar);
            __builtin_amdgcn_fence(__ATOMIC_ACQUIRE, "agent");
            asm volatile("s_waitcnt vmcnt(0)" ::: "memory");
        }
    }
    __syncthreads();
}

struct Args {
    const float* in[19]; float* out; unsigned char* ws; int ph_lo, ph_hi, li, pad;
};
struct Frame {
    LAS unsigned char* lds; LAS unsigned char* misc;
    int G, bid;
    const float *xp, *xs, *st_pool, *st_conv, *st_ret, *norm1_g, *w_in, *pool_w, *pool_scale, *conv_w, *ret_norm_g, *sgu_norm_g, *sgu_w, *sgu_b, *w_out, *norm2_g, *w_gu, *w_dn, *final_g;
    float* out;
    float *ROPE, *SSQ1, *SSQ2, *SSQS1, *SSQS2, *H, *KV, *SPART; unsigned* sgate; unsigned* fillq;
    bf16_t *POOLW, *SGUW, *WIN, *WOUT, *WGU, *WDN, *HB, *PB, *MIX, *ACT, *SB;
};

DI unsigned off_b(unsigned row, unsigned ch) { return 256u * row + 16u * (ch ^ (((row & 3u) << 2) | ((row >> 2) & 3u))); }
DI bf16x8 lds_rowfrag(const LAS unsigned char* tile, int lane, int rb, int s) { return *(const LAS bf16x8*)(tile + off_b((unsigned)((lane & 15) + 16 * rb), (unsigned)(4 * s + (lane >> 4)))); }
DI bf16x8 lds_trfrag(const LAS unsigned char* tile, int lane, int c, int ks) {
    const unsigned g = lane >> 4, q = (lane & 15) >> 2, p = lane & 3;
    const unsigned a0 = off_b(32u * ks + 8u * g + q, 2u * c + (p >> 1)) + 8u * (p & 1);
    const unsigned a1 = off_b(32u * ks + 8u * g + 4u + q, 2u * c + (p >> 1)) + 8u * (p & 1);
    const s16x4 lo = __builtin_amdgcn_ds_read_tr16_b64_v4i16((LAS s16x4*)(tile + a0));
    const s16x4 hi = __builtin_amdgcn_ds_read_tr16_b64_v4i16((LAS s16x4*)(tile + a1));
    return __builtin_shufflevector(lo, hi, 0, 1, 2, 3, 4, 5, 6, 7);
}
#define MFMA16(a, b, c) __builtin_amdgcn_mfma_f32_16x16x32_bf16((a), (b), (c), 0, 0, 0)

constexpr float LG2_GAMMA[4] = {-0.04580368961312479f, -0.02272007650008353f, -0.011315313227834146f, -0.005646563141142063f};
DI float lg2_gamma(int h) { return h == 0 ? LG2_GAMMA[0] : h == 1 ? LG2_GAMMA[1] : h == 2 ? LG2_GAMMA[2] : LG2_GAMMA[3]; }

constexpr int EPS_STRIDE = 132;
DI void epi_scatter(LAS float* scr, const f32x4 (&acc)[8], int lane) {
#pragma unroll
    for (int c = 0; c < 8; ++c)
#pragma unroll
        for (int r = 0; r < 4; ++r) scr[(4 * (lane >> 4) + r) * EPS_STRIDE + 16 * c + (lane & 15)] = acc[c][r];
}
DI void epi_gather(const LAS float* scr, int lane, int p, float (&v)[8]) {
    const LAS float* s = scr + (4 * p + (lane >> 4)) * EPS_STRIDE + 8 * (lane & 15);
    const f32x4 a = *(const LAS f32x4*)s, b = *(const LAS f32x4*)(s + 4);
    v[0] = a[0]; v[1] = a[1]; v[2] = a[2]; v[3] = a[3]; v[4] = b[0]; v[5] = b[1]; v[6] = b[2]; v[7] = b[3];
}
DI void unpack8(const u32x4 w, float (&x)[8]) { x[0] = bflo(w.x); x[1] = bfhi(w.x); x[2] = bflo(w.y); x[3] = bfhi(w.y); x[4] = bflo(w.z); x[5] = bfhi(w.z); x[6] = bflo(w.w); x[7] = bfhi(w.w); }
DI u32x4 pack8(const float (&x)[8]) { u32x4 w; w.x = pk2(x[0], x[1]); w.y = pk2(x[2], x[3]); w.z = pk2(x[4], x[5]); w.w = pk2(x[6], x[7]); return w; }

constexpr int WI_IN = (D / 64) * (INW / 64), WI_OUT = (D / 64) * (D / 64), WI_GU = (D / 64) * (GU / 64), WI_DN = (FF / 64) * (D / 64);
constexpr int WO_OUT = WI_IN, WO_GU = WO_OUT + WI_OUT, WO_DN = WO_GU + WI_GU, WI_L = WO_DN + WI_DN;
#ifndef HF_IN
#define HF_IN 3700
#endif
#ifndef HF_GU
#define HF_GU 2900
#endif
struct WItem { const float* wp; const float* gk; bf16_t* dst; int N, K; };
DI WItem witem_desc(Frame& F, int l, int r, int lane) {
    const float* W; const float* gk; bf16_t* WT; int N, K, item; bool gumap = false;
    if (r < WO_OUT) { W = F.w_in + (size_t)l * D * INW; WT = F.WIN + (size_t)l * INW * KPD; gk = F.norm1_g + l * D; N = INW; K = KPD; item = r; }
    else if (r < WO_GU) { W = F.w_out + (size_t)l * D * D; WT = F.WOUT + (size_t)l * D * KPD; gk = nullptr; N = D; K = KPD; item = r - WO_OUT; }
    else if (r < WO_DN) { W = F.w_gu + (size_t)l * D * GU; WT = F.WGU + (size_t)l * GU * KPD; gk = F.norm2_g + l * D; N = GU; K = KPD; item = r - WO_GU; gumap = true; }
    else { W = F.w_dn + (size_t)l * FF * D; WT = F.WDN + (size_t)l * D * KPF; gk = nullptr; N = D; K = KPF; item = r - WO_DN; }
    const int nblk = N / 64, kb = item / nblk, nb = item - kb * nblk, k0 = 64 * kb, n0 = 64 * nb;
    int d0 = n0; if (gumap) d0 = (n0 < FF) ? ((n0 >> 7) * 256 + (n0 & 127)) : (((n0 - FF) >> 7) * 256 + 128 + ((n0 - FF) & 127));
    WItem w; w.wp = W + (size_t)(k0 + (lane >> 4)) * N + n0 + 4 * (lane & 15); w.gk = gk ? gk + k0 : nullptr; w.dst = WT + (size_t)d0 * K + k0; w.N = N; w.K = K; return w;
}
DI void witem_load(const WItem& w, f32x4 (&v)[16]) {
#pragma unroll
    for (int i = 0; i < 16; ++i) v[i] = *(const f32x4*)(w.wp + (size_t)(4 * i) * w.N);
}
DI void witem_finish(const WItem& w, const f32x4 (&v)[16], LAS float* scr, int lane) {
#pragma unroll
    for (int i = 0; i < 16; ++i) { const int k = 4 * i + (lane >> 4); const float g = w.gk ? w.gk[k] : 1.0f; LAS float* d = scr + k * 65 + 4 * (lane & 15);
        d[0] = v[i][0] * g; d[1] = v[i][1] * g; d[2] = v[i][2] * g; d[3] = v[i][3] * g; }
    asm volatile("s_waitcnt lgkmcnt(0)" ::: "memory");
    const int c = lane & 7;
#pragma unroll
    for (int j = 0; j < 8; ++j) { const int n = (lane >> 3) + 8 * j; const LAS float* s = scr + (8 * c) * 65 + n;
        u32x4 o; o.x = pk2(s[0 * 65], s[1 * 65]); o.y = pk2(s[2 * 65], s[3 * 65]); o.z = pk2(s[4 * 65], s[5 * 65]); o.w = pk2(s[6 * 65], s[7 * 65]);
        *(u32x4*)(w.dst + (size_t)n * w.K + 8 * c) = o; }
    asm volatile("s_waitcnt lgkmcnt(0)" ::: "memory");
}
DI void weight_stream(Frame& F, int l, int first, int hi, int stride, LAS float* scr, int lane) {
    int it = first; if (it >= hi) return;
    f32x4 va[16], vb[16];
    WItem wa = witem_desc(F, l, it, lane), wb = wa; witem_load(wa, va);
    for (;;) {
        const int n1 = it + stride; const bool h1 = n1 < hi;
        if (h1) { wb = witem_desc(F, l, n1, lane); witem_load(wb, vb); }
        witem_finish(wa, va, scr, lane);
        if (!h1) break;
        const int n2 = n1 + stride; const bool h2 = n2 < hi;
        if (h2) { wa = witem_desc(F, l, n2, lane); witem_load(wa, va); }
        witem_finish(wb, vb, scr, lane);
        if (!h2) break;
        it = n2;
    }
}
DI void hole_fill(Frame& F, int first_idle, int n_idle, int l, int lo, int hi) {
    const int tid = opaque_tid(), lane = tid & 63, wave = __builtin_amdgcn_readfirstlane(tid >> 6);
    LAS float* scr = (LAS float*)(F.lds + wave * 16640);
    const bool split = first_idle > 0 && first_idle < F.G;
    if (n_idle < 0) n_idle = 0;
    const int mid = !split ? lo : (lo + n_idle < hi) ? lo + n_idle : hi;
    if (split && F.bid >= first_idle) weight_stream(F, l, lo + (F.bid - first_idle) * 8 + wave, mid, (F.G - first_idle) * 8, scr, lane);
    weight_stream(F, l, mid + F.bid * 8 + wave, hi, F.G * 8, scr, lane);
}
DI void p0_prologue(Frame& F) {
    const int tid = opaque_tid(), lane = tid & 63, wave = __builtin_amdgcn_readfirstlane(tid >> 6);
    LAS float* scr = (LAS float*)(F.lds + wave * 16640);
    const int gw = F.bid * 8 + wave, NGW = F.G * 8;
    weight_stream(F, 0, gw, WI_IN, NGW, scr, lane);
    if (FILL_MODE == 0) { weight_stream(F, 0, WI_IN + gw, WI_L, NGW, scr, lane); weight_stream(F, 1, gw, WI_L, NGW, scr, lane); }
    const int n2 = (WI_IN > NGW) ? WI_IN - NGW : 0, n1 = NGW - n2;
    const int rows_a = (n1 * 5 <= MV) ? n1 * 5 : 0;
    for (int k = 0; k < 5 + (MV - rows_a + NGW - 1) / NGW; ++k) {
        int m;
        if (k < 5) { if (rows_a == 0 || gw < n2) continue; m = (gw - n2) + k * n1; if (m >= rows_a) continue; }
        else { m = rows_a + gw + (k - 5) * NGW; if (m >= MV) continue; }
        const float* xrow = (m < MPR) ? F.xp + (size_t)m * D : F.xs + (size_t)(m - MPR) * D;
        const f32x4* xr = (const f32x4*)xrow + lane; float ss = 0.f; u32x2* o8 = (u32x2*)(F.HB + (size_t)m * D) + lane;
#pragma unroll
        for (int j = 0; j < 8; ++j) { const f32x4 v = xr[64 * j]; ss += (v[0] * v[0] + v[1] * v[1]) + (v[2] * v[2] + v[3] * v[3]); u32x2 w; w.x = pk2(v[0], v[1]); w.y = pk2(v[2], v[3]); o8[64 * j] = w; }
        ss = wave_sum(ss);
        if (m < MPR) { if (lane < 8) F.SSQ1[(size_t)m * 8 + lane] = (lane == 0) ? ss : 0.f; }
        else { F.SSQS1[(size_t)(m - MPR) * 128 + lane] = (lane == 0) ? ss : 0.f; F.SSQS1[(size_t)(m - MPR) * 128 + 64 + lane] = 0.f; }
    }
    const int gt = F.bid * 512 + tid, NGT = F.G * 512;
    for (int i = gt; i < 2049 * 64; i += NGT) { const int pi = i >> 6, f = i & 63; const float pos = (pi < 2048) ? (float)pi : 16384.0f;
        double pw = 1.0, bs = 0.8659643233600653523531691834202299819398;
#pragma unroll
        for (int bit = 0; bit < 6; ++bit) { if ((f >> bit) & 1) pw *= bs; bs *= bs; }
        const float inv = (float)pw; const float ang = pos * inv;
        const double a = (double)ang, kq = __builtin_rint(a * 0.63661977236758134308);
        double r = __builtin_fma(-kq, 1.57079632679489655800e+00, a); r = __builtin_fma(-kq, 6.12323399573676603587e-17, r);
        const double r2 = r * r;
        const double sp = r * (1.0 + r2 * (-1.0 / 6.0 + r2 * (1.0 / 120.0 + r2 * (-1.0 / 5040.0 + r2 * (1.0 / 362880.0 + r2 * (-1.0 / 39916800.0 + r2 * (1.0 / 6227020800.0 + r2 * (-1.0 / 1307674368000.0))))))));
        const double cp = 1.0 + r2 * (-0.5 + r2 * (1.0 / 24.0 + r2 * (-1.0 / 720.0 + r2 * (1.0 / 40320.0 + r2 * (-1.0 / 3628800.0 + r2 * (1.0 / 479001600.0 + r2 * (-1.0 / 87178291200.0 + r2 * (1.0 / 20922789888000.0))))))));
        const int q = (int)((long long)kq & 3);
        const double sn = (q == 0) ? sp : (q == 1) ? cp : (q == 2) ? -sp : -cp, cs = (q == 0) ? cp : (q == 1) ? -sp : (q == 2) ? -cp : sp;
        F.ROPE[2 * i] = (float)cs; F.ROPE[2 * i + 1] = (float)sn; }
    for (int i = gt; i < DEPTH * 4 * 128 * 128; i += NGT) { const int e = i & 127, g4 = (i >> 14) & 3, l = i >> 16;
        F.POOLW[i] = (bf16_t)(pk2(F.pool_w[i] * F.pool_scale[l * 512 + g4 * 128 + e], 0.f) & 0xffffu);
        const int s = i & 127, t = (i >> 7) & 127; F.SGUW[i] = (bf16_t)(pk2(t >= s ? F.sgu_w[i] : 0.f, 0.f) & 0xffffu); }
}

template <class RowMul>
DI void stage_rot(LAS unsigned char* tile, const bf16_t* src, const float* rope_pos0, int tid, RowMul rowmul) {
#pragma unroll
    for (int it = 0; it < 2; ++it) { const int task = tid + 512 * it, row = task >> 3, cp = task & 7;
        const u32x4 lo = *(const u32x4*)(src + (size_t)row * INW + 8 * cp), hi = *(const u32x4*)(src + (size_t)row * INW + 64 + 8 * cp);
        const f32x4* rp = (const f32x4*)(rope_pos0 + (size_t)row * 128 + 16 * cp);
        const f32x4 r0 = rp[0], r1 = rp[1], r2 = rp[2], r3 = rp[3];
        const float cs[8] = {r0[0], r0[2], r1[0], r1[2], r2[0], r2[2], r3[0], r3[2]}, sn[8] = {r0[1], r0[3], r1[1], r1[3], r2[1], r2[3], r3[1], r3[3]};
        float x1[8], x2[8], o1[8], o2[8]; unpack8(lo, x1); unpack8(hi, x2); const float sc = rowmul(row);
#pragma unroll
        for (int i = 0; i < 8; ++i) { o1[i] = (x1[i] * cs[i] - x2[i] * sn[i]) * sc; o2[i] = (x2[i] * cs[i] + x1[i] * sn[i]) * sc; }
        *(LAS u32x4*)(tile + off_b(row, cp)) = pack8(o1); *(LAS u32x4*)(tile + off_b(row, cp + 8)) = pack8(o2); }
}
DI void stage_copy(LAS unsigned char* tile, const bf16_t* src, int pitch, int tid) {
#pragma unroll
    for (int it = 0; it < 4; ++it) { const int task = tid + 512 * it, row = task >> 4, ch = task & 15;
        *(LAS u32x4*)(tile + off_b(row, ch)) = *(const u32x4*)(src + (size_t)row * pitch + 8 * ch); }
}

DI void ret_kv_unit(Frame& F, int b, int h, int n) {
    LAS unsigned char* TK = F.lds; LAS unsigned char* TV = F.lds + 32768;
    const int tid = opaque_tid(), lane = tid & 63, w = __builtin_amdgcn_readfirstlane(tid >> 6); const float lg = lg2_gamma(h);
    __syncthreads();
    const size_t row0 = (size_t)b * SEQ + (size_t)n * 128;
    stage_rot(TK, F.PB + row0 * INW + C_K + h * 128, F.ROPE + (size_t)(n * 128) * 128, tid, [lg](int row) { return 0.08838834764831845f * exp2f((float)(127 - row) * lg); });
    stage_copy(TV, F.PB + row0 * INW + C_V + h * 128, INW, tid);
    __syncthreads();
    f32x4 acc[8];
#pragma unroll
    for (int c = 0; c < 8; ++c) acc[c] = (f32x4){0.f, 0.f, 0.f, 0.f};
#pragma unroll
    for (int ks = 0; ks < 4; ++ks) { const bf16x8 a = lds_trfrag(TK, lane, w, ks);
#pragma unroll
        for (int c = 0; c < 8; ++c) { const bf16x8 bb = lds_trfrag(TV, lane, c, ks); acc[c] = MFMA16(a, bb, acc[c]); } }
    float* kv = F.KV + ((size_t)((b * 4 + h) * NCH + n)) * 16384;
#pragma unroll
    for (int c = 0; c < 8; ++c)
#pragma unroll
        for (int r = 0; r < 4; ++r) kv[(16 * w + 4 * (lane >> 4) + r) * 128 + 16 * c + (lane & 15)] = acc[c][r];
}

DI void ret_out_unit(Frame& F, int l, int b, int h, int n) {
    LAS unsigned char* TQ = F.lds; LAS unsigned char* TK = F.lds + 32768; LAS unsigned char* TV = F.lds + 65536; LAS unsigned char* TS = F.lds + 98304;
    const int tid = opaque_tid(), lane = tid & 63, w = __builtin_amdgcn_readfirstlane(tid >> 6); const float lg = lg2_gamma(h);
    __syncthreads();
    const size_t row0 = (size_t)b * SEQ + (size_t)n * 128;
    const float* rope0 = F.ROPE + (size_t)(n * 128) * 128;
    stage_rot(TQ, F.PB + row0 * INW + C_Q + h * 128, rope0, tid, [](int) { return 1.0f; });
    stage_rot(TK, F.PB + row0 * INW + C_K + h * 128, rope0, tid, [](int) { return 0.08838834764831845f; });
    stage_copy(TV, F.PB + row0 * INW + C_V + h * 128, INW, tid);
    if (n > 0) stage_copy(TS, F.SB + ((size_t)((b * 4 + h) * NCH + n)) * 16384, 128, tid);
    __syncthreads();
    f32x4 acc[8];
#pragma unroll
    for (int c = 0; c < 8; ++c) acc[c] = (f32x4){0.f, 0.f, 0.f, 0.f};
    bf16x8 qf[4];
#pragma unroll
    for (int s = 0; s < 4; ++s) qf[s] = lds_rowfrag(TQ, lane, w, s);
    if (n > 0) {
#pragma unroll
        for (int s = 0; s < 4; ++s)
#pragma unroll
            for (int c = 0; c < 8; ++c) { const bf16x8 bb = lds_trfrag(TS, lane, c, s); acc[c] = MFMA16(qf[s], bb, acc[c]); }
        float f[4];
#pragma unroll
        for (int r = 0; r < 4; ++r) f[r] = exp2f((float)(16 * w + 4 * (lane >> 4) + r + 1) * lg);
#pragma unroll
        for (int c = 0; c < 8; ++c)
#pragma unroll
            for (int r = 0; r < 4; ++r) acc[c][r] *= f[r];
    }
    const int i_loc = 16 * w + (lane & 15);
#pragma unroll
    for (int c = 0; c < 8; ++c) if (c <= w) {
        f32x4 sc = (f32x4){0.f, 0.f, 0.f, 0.f};
#pragma unroll
        for (int s = 0; s < 4; ++s) { const bf16x8 kf = lds_rowfrag(TK, lane, c, s); sc = MFMA16(kf, qf[s], sc); }
        float pv[4];
#pragma unroll
        for (int r = 0; r < 4; ++r) { const int j = 16 * c + 4 * (lane >> 4) + r; const int dd = i_loc - j; pv[r] = dd >= 0 ? sc[r] * exp2f((float)dd * lg) : 0.f; }
        u32x2 o; o.x = pk2(pv[0], pv[1]); o.y = pk2(pv[2], pv[3]);
        *(LAS u32x2*)(TQ + off_b(i_loc, 2 * c + (lane >> 5)) + 8 * ((lane >> 4) & 1)) = o;
    }
    if ((w & 1) == 0) { unsigned zz = 0u; asm volatile("" : "+v"(zz)); u32x2 z; z.x = zz; z.y = zz; *(LAS u32x2*)(TQ + off_b(i_loc, 2 * (w + 1) + (lane >> 5)) + 8 * ((lane >> 4) & 1)) = z; }
#pragma unroll
    for (int ks = 0; ks < 4; ++ks) if (ks <= (w >> 1)) { const bf16x8 a = lds_rowfrag(TQ, lane, w, ks);
#pragma unroll
        for (int c = 0; c < 8; ++c) { const bf16x8 bb = lds_trfrag(TV, lane, c, ks); acc[c] = MFMA16(a, bb, acc[c]); } }
#pragma unroll
    for (int r = 0; r < 4; ++r) { float s = 0.f;
#pragma unroll
        for (int c = 0; c < 8; ++c) s += acc[c][r];
        s += __shfl_xor(s, 1); s += __shfl_xor(s, 2); s += __shfl_xor(s, 4); s += __shfl_xor(s, 8);
        const float mean = s * (1.0f / 128.0f); float q = 0.f;
#pragma unroll
        for (int c = 0; c < 8; ++c) { const float d = acc[c][r] - mean; acc[c][r] = d; q += d * d; }
        q += __shfl_xor(q, 1); q += __shfl_xor(q, 2); q += __shfl_xor(q, 4); q += __shfl_xor(q, 8);
        const float rstd = __builtin_amdgcn_rsqf(q * (1.0f / 128.0f) + NORM_EPS);
#pragma unroll
        for (int c = 0; c < 8; ++c) acc[c][r] *= rstd; }
    __syncthreads();
    LAS float* scr = (LAS float*)(F.lds + w * 8448);
    epi_scatter(scr, acc, lane);
    const float* gn = F.ret_norm_g + l * 512 + h * 128 + 8 * (lane & 15);
    const f32x4 g0 = *(const f32x4*)gn, g1 = *(const f32x4*)(gn + 4);
    const float gg[8] = {g0[0], g0[1], g0[2], g0[3], g1[0], g1[1], g1[2], g1[3]};
#pragma unroll
    for (int p = 0; p < 4; ++p) { float v[8]; epi_gather(scr, lane, p, v); const size_t grow = row0 + 16 * w + 4 * p + (lane >> 4);
        float gt[8]; unpack8(*(const u32x4*)(F.PB + grow * INW + C_G + h * 128 + 8 * (lane & 15)), gt);
#pragma unroll
        for (int i = 0; i < 8; ++i) v[i] = v[i] * gg[i] * silu_f(gt[i]);
        *(u32x4*)(F.MIX + grow * D + 1024 + h * 128 + 8 * (lane & 15)) = pack8(v); }
}

DI void pool_unit(Frame& F, int l, int b, int tt, int gi) {
    LAS unsigned char* TA = F.lds; LAS unsigned char* TD = F.lds + 40960; LAS unsigned char* TW = F.lds + 73728;
    const int tid = opaque_tid(), lane = tid & 63, w = __builtin_amdgcn_readfirstlane(tid >> 6);
    __syncthreads();
    for (int task = tid; task < 143 * 16; task += 512) { const int r = task >> 4, ch = task & 15, tseq = tt * 128 - 15 + r;
        u32x4 v = (u32x4){0u, 0u, 0u, 0u};
        if (tseq >= 0) v = *(const u32x4*)(F.PB + ((size_t)b * SEQ + tseq) * INW + C_A + gi * 128 + 8 * ch);
        *(LAS u32x4*)(TA + r * 256 + ch * 16) = v; }
    stage_copy(TW, F.POOLW + (size_t)((l * 4 + gi) * 128) * 128, 128, tid);
    __syncthreads();
    const int win = 2 << gi;
#pragma unroll
    for (int it = 0; it < 4; ++it) { const int task = tid + 512 * it, t = task >> 4, ch = task & 15;
        float s[8], a[8];
        unpack8(*(const LAS u32x4*)(TA + (t + 15) * 256 + ch * 16), a);
#pragma unroll
        for (int i = 0; i < 8; ++i) s[i] = a[i];
        for (int j = 1; j < win; ++j) { float x[8]; unpack8(*(const LAS u32x4*)(TA + (t + 15 - j) * 256 + ch * 16), x);
#pragma unroll
            for (int i = 0; i < 8; ++i) s[i] += x[i]; }
        const int pos = tt * 128 + t; const float inv = 1.0f / (float)(pos + 1 < win ? pos + 1 : win);
        float d[8];
#pragma unroll
        for (int i = 0; i < 8; ++i) d[i] = s[i] * inv - a[i];
        *(LAS u32x4*)(TD + off_b(t, ch)) = pack8(d);
        if (tt == NCH - 1 && t >= 113) { float* o = F.out + O_POOLP + ((size_t)((l * NB + b) * 15 + (t - 113))) * 512 + gi * 128 + 8 * ch;
            *(f32x4*)o = (f32x4){a[0], a[1], a[2], a[3]}; *(f32x4*)(o + 4) = (f32x4){a[4], a[5], a[6], a[7]}; }
    }
    __syncthreads();
    f32x4 acc[8];
#pragma unroll
    for (int c = 0; c < 8; ++c) acc[c] = (f32x4){0.f, 0.f, 0.f, 0.f};
#pragma unroll
    for (int s = 0; s < 4; ++s) { const bf16x8 a = lds_rowfrag(TD, lane, w, s);
#pragma unroll
        for (int c = 0; c < 8; ++c) { const bf16x8 bb = lds_trfrag(TW, lane, c, s); acc[c] = MFMA16(a, bb, acc[c]); } }
    __syncthreads();
    LAS float* scr = (LAS float*)(F.lds + w * 8448);
    epi_scatter(scr, acc, lane);
#pragma unroll
    for (int p = 0; p < 4; ++p) { float v[8]; epi_gather(scr, lane, p, v); const size_t grow = (size_t)b * SEQ + tt * 128 + 16 * w + 4 * p + (lane >> 4);
        *(u32x4*)(F.MIX + grow * D + gi * 128 + 8 * (lane & 15)) = pack8(v); }
}

DI void sgu_unit(Frame& F, int l, int b, int ck, int h) {
    LAS unsigned char* TV = F.lds;
    const int tid = opaque_tid(), lane = tid & 63, w = __builtin_amdgcn_readfirstlane(tid >> 6);
    __syncthreads();
    const size_t row0 = (size_t)b * SEQ + (size_t)ck * 128;
    { const float* gp = F.sgu_norm_g + l * 512 + 8 * lane; const f32x4 g0 = *(const f32x4*)gp, g1 = *(const f32x4*)(gp + 4);
      const float gg[8] = {g0[0], g0[1], g0[2], g0[3], g1[0], g1[1], g1[2], g1[3]};
      for (int it = 0; it < 16; ++it) { const int st = 16 * w + it;
        float x[8]; unpack8(*(const u32x4*)(F.PB + (row0 + st) * INW + C_VV + 8 * lane), x);
        float s = ((x[0] + x[1]) + (x[2] + x[3])) + ((x[4] + x[5]) + (x[6] + x[7]));
        const float mean = wave_sum(s) * (1.0f / 512.0f); float q = 0.f;
#pragma unroll
        for (int i = 0; i < 8; ++i) { x[i] -= mean; q += x[i] * x[i]; }
        const float rstd = __builtin_amdgcn_rsqf(wave_sum(q) * (1.0f / 512.0f) + NORM_EPS);
        if ((lane >> 4) == h) {
#pragma unroll
            for (int i = 0; i < 8; ++i) x[i] = x[i] * rstd * gg[i];
            *(LAS u32x4*)(TV + off_b(st, lane & 15)) = pack8(x);
            if (ck == NCH - 1) { float* o = F.out + O_SGUP + ((size_t)((l * NB + b) * 128 + st)) * 512 + 8 * lane;
                *(f32x4*)o = (f32x4){x[0], x[1], x[2], x[3]}; *(f32x4*)(o + 4) = (f32x4){x[4], x[5], x[6], x[7]}; } } } }
    __syncthreads();
    f32x4 acc[8];
#pragma unroll
    for (int c = 0; c < 8; ++c) acc[c] = (f32x4){0.f, 0.f, 0.f, 0.f};
    const bf16_t* wrow = F.SGUW + ((size_t)((l * 4 + h) * 128 + 16 * w + (lane & 15))) * 128 + 8 * (lane >> 4);
#pragma unroll
    for (int ks = 0; ks < 4; ++ks) if (ks <= (w >> 1)) { const bf16x8 a = *(const bf16x8*)(wrow + 32 * ks);
#pragma unroll
        for (int c = 0; c < 8; ++c) { const bf16x8 bb = lds_trfrag(TV, lane, c, ks); acc[c] = MFMA16(a, bb, acc[c]); } }
    __syncthreads();
    LAS float* scr = (LAS float*)(F.lds + w * 8448);
    epi_scatter(scr, acc, lane);
#pragma unroll
    for (int p = 0; p < 4; ++p) { float v[8]; epi_gather(scr, lane, p, v); const int t = 16 * w + 4 * p + (lane >> 4); const size_t grow = row0 + t;
        const float bias = F.sgu_b[(l * 4 + h) * 128 + t];
        float u[8]; unpack8(*(const u32x4*)(F.PB + grow * INW + C_U + h * 128 + 8 * (lane & 15)), u);
#pragma unroll
        for (int i = 0; i < 8; ++i) v[i] = u[i] * (v[i] + bias);
        *(u32x4*)(F.MIX + grow * D + 1536 + h * 128 + 8 * (lane & 15)) = pack8(v); }
}

DI void conv_flat(Frame& F, int l) {
    const float* cw = F.conv_w + l * 3 * 512; const int tid = opaque_tid();
    const int b0 = (F.G == 256) ? 128 : 0;
    if (F.bid < b0) return;
    for (int task = (F.bid - b0) * 512 + tid; task < MPR * 64; task += (F.G - b0) * 512) { const int row = task >> 6, ch = task & 63, t = row & (SEQ - 1), b = row >> 11;
        const bf16_t* p = F.PB + (size_t)row * INW + 8 * ch;
        float z[3][8];
#pragma unroll
        for (int k = 0; k < 3; ++k) { const int back = 2 - k;
            if (t - back >= 0) { float cg[8], hh[8]; unpack8(*(const u32x4*)(p - (size_t)back * INW + C_CG), cg); unpack8(*(const u32x4*)(p - (size_t)back * INW + C_HH), hh);
#pragma unroll
                for (int i = 0; i < 8; ++i) z[k][i] = cg[i] * hh[i]; }
            else {
#pragma unroll
                for (int i = 0; i < 8; ++i) z[k][i] = 0.f; } }
        float bg[8], y[8]; unpack8(*(const u32x4*)(p + C_BG), bg);
#pragma unroll
        for (int i = 0; i < 8; ++i) { const int c = 8 * ch + i; y[i] = bg[i] * (z[0][i] * cw[c] + z[1][i] * cw[512 + c] + z[2][i] * cw[1024 + c]); }
        *(u32x4*)(F.MIX + (size_t)row * D + 512 + 8 * ch) = pack8(y);
        if (t >= SEQ - 2) { float* o = F.out + O_CONVP + ((size_t)((l * NB + b) * 2 + (t - (SEQ - 2)))) * 512 + 8 * ch;
            *(f32x4*)o = (f32x4){z[2][0], z[2][1], z[2][2], z[2][3]}; *(f32x4*)(o + 4) = (f32x4){z[2][4], z[2][5], z[2][6], z[2][7]}; }
    }
}

DI void ret_scan_flat(Frame& F, int l) {
    const int tid = opaque_tid();
    for (int task = F.bid * 512 + tid; task < 16 * 4096; task += F.G * 512) { const int bh = task >> 12, e4 = task & 4095, h = bh & 3; const float g = exp2f(128.0f * lg2_gamma(h));
        const float* kvb = F.KV + (size_t)bh * NCH * 16384 + 4 * e4; bf16_t* sb = F.SB + (size_t)bh * NCH * 16384 + 4 * e4;
        f32x4 kv[NCH];
#pragma unroll
        for (int m = 0; m < NCH; ++m) kv[m] = *(const f32x4*)(kvb + (size_t)m * 16384);
        f32x4 st = kv[0];
#pragma unroll
        for (int n = 1; n < NCH; ++n) { u32x2 o; o.x = pk2(st[0], st[1]); o.y = pk2(st[2], st[3]); *(u32x2*)(sb + (size_t)n * 16384) = o; st = st * g + kv[n]; }
        *(f32x4*)(F.out + O_RETP + ((size_t)(l * 16 + bh)) * 16384 + 4 * e4) = st; }
}

DI void sret_unit(Frame& F, int l, int s, int h) {
    LAS float* qf = (LAS float*)F.lds; LAS float* kf = qf + 128; LAS float* vf = qf + 256; LAS float* red = qf + 384;
    const int tid = opaque_tid(), lane = tid & 63; const size_t row = (size_t)MPR + s; const float gam = exp2f(lg2_gamma(h));
    __syncthreads();
    if (tid < 64) { const bf16_t* p = F.PB + row * INW + h * 128; const float* rp = F.ROPE + ((size_t)ROPE_SPOS * 64 + tid) * 2; const float cs = rp[0], sn = rp[1];
        const float q1 = bf2f(p[C_Q + tid]), q2 = bf2f(p[C_Q + 64 + tid]), k1 = bf2f(p[C_K + tid]), k2 = bf2f(p[C_K + 64 + tid]);
        qf[tid] = q1 * cs - q2 * sn; qf[tid + 64] = q2 * cs + q1 * sn;
        kf[tid] = (k1 * cs - k2 * sn) * 0.08838834764831845f; kf[tid + 64] = (k2 * cs + k1 * sn) * 0.08838834764831845f;
        vf[tid] = bf2f(p[C_V + tid]); vf[tid + 64] = bf2f(p[C_V + 64 + tid]); }
    __syncthreads();
    const int dg = tid >> 5, e4 = (tid & 31) * 4;
    const size_t sb = ((size_t)((l * NS + s) * 4 + h)) * 16384;
    const float* s0 = F.st_ret + sb; float* so = F.out + O_RETS + sb;
    const f32x4 vv = *(const LAS f32x4*)(vf + e4); f32x4 o = (f32x4){0.f, 0.f, 0.f, 0.f};
#pragma unroll
    for (int it = 0; it < 8; ++it) { const int d = dg + 16 * it; const f32x4 a = *(const f32x4*)(s0 + d * 128 + e4); const f32x4 sn = a * gam + vv * kf[d];
        *(f32x4*)(so + d * 128 + e4) = sn; o += sn * qf[d]; }
    *(LAS f32x4*)(red + dg * 128 + e4) = o;
    __syncthreads();
    if (tid < 64) { float o0 = 0.f, o1 = 0.f;
#pragma unroll
        for (int g = 0; g < 16; ++g) { o0 += red[g * 128 + lane]; o1 += red[g * 128 + 64 + lane]; }
        const float mean = wave_sum(o0 + o1) * (1.0f / 128.0f); o0 -= mean; o1 -= mean;
        const float rstd = __builtin_amdgcn_rsqf(wave_sum(o0 * o0 + o1 * o1) * (1.0f / 128.0f) + NORM_EPS);
        const bf16_t* gp = F.PB + row * INW + C_G + h * 128; const float* gn = F.ret_norm_g + l * 512 + h * 128;
        bf16_t* mo = F.MIX + row * D + 1024 + h * 128;
        mo[lane] = (bf16_t)(pk2(o0 * rstd * gn[lane] * silu_f(bf2f(gp[lane])), 0.f) & 0xffffu);
        mo[lane + 64] = (bf16_t)(pk2(o1 * rstd * gn[lane + 64] * silu_f(bf2f(gp[lane + 64])), 0.f) & 0xffffu); }
}

DI void smisc_unit(Frame& F, int l, int s) {
    LAS float* dl = (LAS float*)F.lds; LAS float* red = dl + 512;
    const int tid = opaque_tid(), lane = tid & 63, w = __builtin_amdgcn_readfirstlane(tid >> 6); const size_t row = (size_t)MPR + s; const bf16_t* p = F.PB + row * INW;
    __syncthreads();
    {
        const int gi = tid >> 7, win = 2 << gi; const float a0 = bf2f(p[C_A + tid]);
        const float* prev = F.st_pool + ((size_t)(l * NS + s) * 15) * 512 + tid; float* po = F.out + O_POOLS + ((size_t)(l * NS + s) * 15) * 512 + tid;
        float ws = a0;
#pragma unroll
        for (int j = 0; j < 15; ++j) { const float pj = prev[(size_t)j * 512]; if (15 - j < win) ws += pj; if (j >= 1) po[(size_t)(j - 1) * 512] = pj; }
        po[(size_t)14 * 512] = a0;
        dl[tid] = ws / (float)win - a0;
    }
    {
        const float z0 = bf2f(p[C_CG + tid]) * bf2f(p[C_HH + tid]); const float* cw = F.conv_w + l * 3 * 512 + tid;
        const float* pc = F.st_conv + ((size_t)(l * NS + s) * 2) * 512 + tid; const float p0 = pc[0], p1 = pc[512];
        const float y = bf2f(p[C_BG + tid]) * (p0 * cw[0] + p1 * cw[512] + z0 * cw[1024]);
        F.MIX[row * D + 512 + tid] = (bf16_t)(pk2(y, 0.f) & 0xffffu);
        float* co = F.out + O_CONVS + ((size_t)(l * NS + s) * 2) * 512 + tid; co[0] = p1; co[512] = z0;
    }
    const float vvx = bf2f(p[C_VV + tid]);
    { const float sm = wave_sum(vvx); if (lane == 0) red[w] = sm; }
    __syncthreads();
    float mean = 0.f;
#pragma unroll
    for (int i = 0; i < 8; ++i) mean += red[i];
    mean *= (1.0f / 512.0f);
    const float dv = vvx - mean;
    { const float sq = wave_sum(dv * dv); if (lane == 0) red[8 + w] = sq; }
    {
        const int gi = tid >> 7, e = tid & 127; const bf16_t* wp = F.POOLW + ((size_t)(l * 4 + gi) * 128) * 128 + e; float y = 0.f;
#pragma unroll 8
        for (int c = 0; c < 128; ++c) y += dl[gi * 128 + c] * bf2f(wp[(size_t)c * 128]);
        F.MIX[row * D + tid] = (bf16_t)(pk2(y, 0.f) & 0xffffu);
    }
    __syncthreads();
    float var = 0.f;
#pragma unroll
    for (int i = 0; i < 8; ++i) var += red[8 + i];
    const float rstd = __builtin_amdgcn_rsqf(var * (1.0f / 512.0f) + NORM_EPS);
    const float vn = dv * rstd * F.sgu_norm_g[l * 512 + tid];
    F.out[O_SGUS + (size_t)(l * NS + s) * 512 + tid] = vn;
    const int h = tid >> 7; const float mixed = F.sgu_w[(size_t)(l * 4 + h) * 16384] * vn + F.sgu_b[(l * 4 + h) * 128];
    F.MIX[row * D + 1536 + tid] = (bf16_t)(pk2(bf2f(p[C_U + tid]) * mixed, 0.f) & 0xffffu);
}

template <int KS>
DI void skinny_splitk_piece(LAS unsigned char* lds, const bf16_t* A, int lda, const bf16_t* Bt, int ldb, int piece, float* SP) {
    const int tid = opaque_tid(), lane = tid & 63, w = __builtin_amdgcn_readfirstlane(tid >> 6);
    const int cb = piece & 31, sl = piece >> 5, k0 = sl * KS;
    constexpr int RS = KS * 2 + 16, CPR = KS / 8, NKS = KS / 32;
    __syncthreads();
    for (int c = tid; c < 64 * CPR; c += 512) { const int r = c / CPR, ch = c - r * CPR;
        *(LAS u32x4*)(lds + r * RS + ch * 16) = *(const u32x4*)(Bt + (size_t)(64 * cb + r) * ldb + k0 + 8 * ch); }
    const bf16_t* ap = A + (size_t)(16 * w + (lane & 15)) * lda + k0 + 8 * (lane >> 4);
    bf16x8 af[NKS];
#pragma unroll
    for (int ks = 0; ks < NKS; ++ks) af[ks] = *(const bf16x8*)(ap + 32 * ks);
    __syncthreads();
    f32x4 acc[4];
#pragma unroll
    for (int c = 0; c < 4; ++c) acc[c] = (f32x4){0.f, 0.f, 0.f, 0.f};
    const LAS unsigned char* bp = lds + (lane & 15) * RS + (lane >> 4) * 16;
#pragma unroll
    for (int ks = 0; ks < NKS; ++ks)
#pragma unroll
        for (int c = 0; c < 4; ++c) { const bf16x8 bb = *(const LAS bf16x8*)(bp + 16 * c * RS + 64 * ks); acc[c] = MFMA16(bb, af[ks], acc[c]); }
    float* o = SP + ((size_t)sl * NS + 16 * w + (lane & 15)) * D + 64 * cb + 4 * (lane >> 4);
#pragma unroll
    for (int c = 0; c < 4; ++c) *(f32x4*)(o + 16 * c) = acc[c];
}
template <bool BASE_BF16, bool OUT_F32>
DI void sample_finalize(const float* SP, int r, const float* base_f, const bf16_t* base_b, float* Hs, bf16_t* HBs, float* ssqs) {
    const int tid = opaque_tid(), lane = tid & 63, w = __builtin_amdgcn_readfirstlane(tid >> 6);
    const size_t off = (size_t)r * D + 256 * w + 4 * lane;
    f32x4 p[8];
#pragma unroll
    for (int sl = 0; sl < 8; ++sl) p[sl] = *(const f32x4*)(SP + (size_t)sl * NS * D + off);
    f32x4 h;
    if (BASE_BF16) { const u32x2 x = *(const u32x2*)(base_b + off); h = (f32x4){bflo(x.x), bfhi(x.x), bflo(x.y), bfhi(x.y)}; } else h = *(const f32x4*)(base_f + off);
#pragma unroll
    for (int sl = 0; sl < 8; ++sl) h += p[sl];
    if (OUT_F32) *(f32x4*)(Hs + off) = h; else { u32x2 o; o.x = pk2(h[0], h[1]); o.y = pk2(h[2], h[3]); *(u32x2*)(HBs + off) = o; }
    const float ss = wave_sum((h[0] * h[0] + h[1] * h[1]) + (h[2] * h[2] + h[3] * h[3]));
    if (lane < 16) ssqs[(size_t)r * 128 + 16 * w + lane] = (lane == 0) ? ss : 0.f;
}

DI void sample_final_row(Frame& F, int r) {
    const int tid = opaque_tid(), lane = tid & 63, w = __builtin_amdgcn_readfirstlane(tid >> 6);
    LAS float* red = (LAS float*)F.misc;
    const size_t off = (size_t)r * D + 256 * w + 4 * lane;
    f32x4 p[8];
#pragma unroll
    for (int sl = 0; sl < 8; ++sl) p[sl] = *(const f32x4*)(F.SPART + (size_t)sl * NS * D + off);
    const u32x2 x = *(const u32x2*)(F.HB + (size_t)MPR * D + off); f32x4 h = (f32x4){bflo(x.x), bfhi(x.x), bflo(x.y), bfhi(x.y)};
#pragma unroll
    for (int sl = 0; sl < 8; ++sl) h += p[sl];
    const float ss = wave_sum((h[0] * h[0] + h[1] * h[1]) + (h[2] * h[2] + h[3] * h[3]));
    __syncthreads();
    if (lane == 0) red[w] = ss;
    __syncthreads();
    float tot = 0.f;
#pragma unroll
    for (int i = 0; i < 8; ++i) tot += red[i];
    const float rs = __builtin_amdgcn_rsqf(tot * (1.0f / (float)D) + NORM_EPS);
    const f32x4 g = *(const f32x4*)(F.final_g + 256 * w + 4 * lane);
    *(f32x4*)(F.out + O_YS + off) = h * rs * g;
}

DI void final_norm(Frame& F) {
    const int tid = opaque_tid(), lane = tid & 63, wave = __builtin_amdgcn_readfirstlane(tid >> 6);
    const int gw = F.bid * 8 + wave, NGW = F.G * 8;
    for (int r = F.bid; r < NS; r += F.G) sample_final_row(F, r);
    for (int m = gw; m < MPR; m += NGW) { const float rs = pg8::row_rstd(F.SSQ1, F.SSQS1, m);
        const u32x2* hr = (const u32x2*)(F.HB + (size_t)m * D) + lane; const f32x4* gr = (const f32x4*)F.final_g + lane;
        f32x4* o = (f32x4*)(F.out + O_YP + (size_t)m * D) + lane;
        u32x2 hv[8];
#pragma unroll
        for (int j = 0; j < 8; ++j) hv[j] = hr[64 * j];
#pragma unroll
        for (int j = 0; j < 8; ++j) { const f32x4 h = (f32x4){bflo(hv[j].x), bfhi(hv[j].x), bflo(hv[j].y), bfhi(hv[j].y)}; o[64 * j] = h * rs * gr[64 * j]; } }
}

constexpr int N_PHASES = 2 + 7 * DEPTH;
#define MKFRAME() Frame F; { const __attribute__((address_space(4))) Args* ap = (const __attribute__((address_space(4))) Args*)__builtin_amdgcn_kernarg_segment_ptr(); asm volatile("" : "+s"(ap)); const __attribute__((address_space(4))) Args& A_ = *ap; unsigned char* ws = A_.ws; \
    F.lds = lds_; F.misc = F.lds + MISC_OFF; F.G = gridDim.x; F.bid = blockIdx.x; \
    F.xp = A_.in[0]; F.xs = A_.in[1]; F.st_pool = A_.in[2]; F.st_conv = A_.in[3]; F.st_ret = A_.in[4]; F.norm1_g = A_.in[5]; F.w_in = A_.in[6]; \
    F.pool_w = A_.in[7]; F.pool_scale = A_.in[8]; F.conv_w = A_.in[9]; F.ret_norm_g = A_.in[10]; F.sgu_norm_g = A_.in[11]; F.sgu_w = A_.in[12]; F.sgu_b = A_.in[13]; \
    F.w_out = A_.in[14]; F.norm2_g = A_.in[15]; F.w_gu = A_.in[16]; F.w_dn = A_.in[17]; F.final_g = A_.in[18]; F.out = A_.out; \
    F.ROPE = (float*)(ws + WS_ROPE); F.SSQ1 = (float*)(ws + WS_SSQ1); F.SSQ2 = (float*)(ws + WS_SSQ2); F.SSQS1 = (float*)(ws + WS_SSQS1); F.SSQS2 = (float*)(ws + WS_SSQS2); F.H = (float*)(ws + WS_H); F.KV = (float*)(ws + WS_KV); F.SPART = (float*)(ws + WS_SPART); F.sgate = (unsigned*)(ws + WS_CTL) + CW_SGATE; F.fillq = (unsigned*)(ws + WS_CTL) + CW_FILL; \
    F.POOLW = (bf16_t*)(ws + WS_POOLW); F.SGUW = (bf16_t*)(ws + WS_SGUW); F.WIN = (bf16_t*)(ws + WS_WIN); F.WOUT = (bf16_t*)(ws + WS_WOUT); F.WGU = (bf16_t*)(ws + WS_WGU); F.WDN = (bf16_t*)(ws + WS_WDN); \
    F.HB = (bf16_t*)(ws + WS_HB); F.PB = (bf16_t*)(ws + WS_PB); F.MIX = (bf16_t*)(ws + WS_MIX); F.ACT = (bf16_t*)(ws + WS_ACT); F.SB = (bf16_t*)(ws + WS_SB); \
    DUMH = (float*)(ws + WS_DUMH); DUMHB = (bf16_t*)(ws + WS_DUMHB); DUMSSQ = (float*)(ws + WS_DUMSSQ); }
#define IN(k) (lo <= (k) && (k) < hi)
#define SEAM(k) do { if (IN(k) && IN((k) + 1)) { unsigned long long ra_ = 0; const bool pb_ = (PROBE_CLK == 8 || PROBE_CLK == 9) && (k) == PROBE_SEAM; if (pb_ && opaque_tid() == 0) ra_ = __builtin_amdgcn_s_memrealtime(); \
    xcd_barrier(bar); for (int xb_ = 0; xb_ < PROBE_XBAR; ++xb_) xcd_barrier(bar); \
    if (pb_ && opaque_tid() == 0) { const unsigned dt_ = (unsigned)(__builtin_amdgcn_s_memrealtime() - ra_); unsigned* cw_ = (unsigned*)args.ws + 8000; atomicMax(cw_ + 5, dt_); atomicMax(cw_ + 6, 100000u - dt_); } } } while (0)
#define REPS(t) ((PROBE_DUP == (t)) ? 2 : 1)
#define REP_BAR(t) do { if (rep + 1 < REPS(t)) xcd_barrier(bar); } while (0)
template <int l>
DI void run_layer(const Args& args, LAS unsigned char* const lds_, const XcdBarrier& bar, const int lo, const int hi) {
    float* DUMH; bf16_t* DUMHB; float* DUMSSQ;
        const int p = 1 + 7 * l;
        if (IN(p)) for (int rep = 0; rep < REPS(1); ++rep) { MKFRAME();
            if (l > 0 && rep + 1 == REPS(1)) {
                for (int r = F.bid; r < NS; r += F.G) {
                    sample_finalize<true, false>(F.SPART, r, nullptr, F.HB + (size_t)MPR * D, nullptr, F.HB + (size_t)MPR * D, F.SSQS1);
                    asm volatile("s_waitcnt vmcnt(0)" ::: "memory"); __syncthreads();
                    if (opaque_tid() == 0) { __builtin_amdgcn_fence(__ATOMIC_RELEASE, "agent"); asm volatile("s_waitcnt vmcnt(0)" ::: "memory"); __hip_atomic_fetch_add(F.sgate, 1u, __ATOMIC_RELAXED, __HIP_MEMORY_SCOPE_AGENT); } }
            }
            pg8::Gemm g{F.HB, F.WIN + (size_t)l * INW * KPD, MP, INW, D, D, KPD}; pg8::GatedOrder S; S.init(MP, INW, F.G, opaque_sgpr(F.bid)); S.cnt = F.sgate; S.need = (l > 0 && rep + 1 == REPS(1)) ? (unsigned)NS : 0u;
            pg8::EpiIn E{F.PB, F.SSQ1, F.SSQS1};
            unsigned long long pr0_ = 0; if ((PROBE_CLK == 10 || PROBE_CLK == 12) && l == 0 && opaque_tid() == 0) pr0_ = __builtin_amdgcn_s_memrealtime();
            pg8::gemm_phase<pg8::EpiIn, pg8::GatedOrder, true, true>(F.lds, F.misc, g, S, E);
            if ((PROBE_CLK == 10 || PROBE_CLK == 12) && l == 0 && opaque_tid() == 0) { const unsigned d_ = (unsigned)(__builtin_amdgcn_s_memrealtime() - pr0_); atomicMax((unsigned*)args.ws + 8007, d_ * 256u + (unsigned)F.bid); }
            if (FILL_MODE == 1) hole_fill(F, (MP / 256) * (INW / 256) - 2 * F.G, HF_IN, l, WO_OUT, WO_DN);
            REP_BAR(1);
        } SEAM(p);
        if (IN(p + 1)) for (int rep = 0; rep < REPS(2); ++rep) { MKFRAME();
            const int NJ = 256 + 512 + 128;
            for (int j = F.bid; j < NJ; j += F.G) {
                if (j < 256) { ret_kv_unit(F, j >> 6, (j >> 4) & 3, j & 15); if (PROBE_UNIT == 1) ret_kv_unit(F, j >> 6, (j >> 4) & 3, j & 15); }
                else if (j < 768) { const int k = j - 256; sret_unit(F, l, k >> 2, k & 3); if (PROBE_UNIT == 2) sret_unit(F, l, k >> 2, k & 3); }
                else { smisc_unit(F, l, j - 768); if (PROBE_UNIT == 3) smisc_unit(F, l, j - 768); }
            }
            conv_flat(F, l); if (PROBE_UNIT == 4) conv_flat(F, l);
            REP_BAR(2);
        } SEAM(p + 1);
        if (IN(p + 2)) for (int rep = 0; rep < REPS(3); ++rep) { MKFRAME();
            ret_scan_flat(F, l); if (PROBE_UNIT == 5) ret_scan_flat(F, l);
            const int NJ = 512;
            for (int j = F.bid; j < NJ; j += F.G) {
                if (j < 256) { pool_unit(F, l, j >> 6, (j >> 2) & 15, j & 3); if (PROBE_UNIT == 6) pool_unit(F, l, j >> 6, (j >> 2) & 15, j & 3); }
                else { const int k = j - 256; sgu_unit(F, l, k >> 6, (k >> 2) & 15, k & 3); if (PROBE_UNIT == 7) sgu_unit(F, l, k >> 6, (k >> 2) & 15, k & 3); }
            }
            __syncthreads();
            REP_BAR(3);
        } SEAM(p + 2);
        if (IN(p + 3)) for (int rep = 0; rep < REPS(4); ++rep) { MKFRAME();
            const bool dm = rep + 1 < REPS(4);
            for (int j = F.bid; j < 256; j += F.G) { ret_out_unit(F, l, j >> 6, (j >> 4) & 3, j & 15); if (PROBE_UNIT == 8) ret_out_unit(F, l, j >> 6, (j >> 4) & 3, j & 15); }
            for (int rp = 0; rp < (PROBE_UNIT == 9 ? 2 : 1); ++rp)
            for (int j = F.bid; j < 256; j += F.G) skinny_splitk_piece<D / 8>(F.lds, F.MIX + (size_t)MPR * D, D, F.WOUT + (size_t)l * D * KPD, KPD, j, F.SPART);
            __syncthreads();
            REP_BAR(4);
        } SEAM(p + 3);
        if (IN(p + 4)) for (int rep = 0; rep < REPS(5); ++rep) { MKFRAME();
            const bool dm = rep + 1 < REPS(5);
            pg8::Gemm g{F.MIX, F.WOUT + (size_t)l * D * KPD, MPR, D, D, D, KPD}; pg8::StaticOrder S; S.init(MPR, D, F.G, opaque_sgpr(F.bid));
            for (int r = F.bid; r < NS; r += F.G)
                sample_finalize<(l > 0), false>(F.SPART, r, F.xs, F.HB + (size_t)MPR * D, nullptr, (dm ? DUMHB : F.HB) + (size_t)MPR * D, dm ? DUMSSQ : F.SSQS2);
            typedef pg8::EpiRes<(l > 0), false> EpiOut;
            EpiOut E{F.xp, F.HB, nullptr, dm ? DUMHB : F.HB, dm ? DUMSSQ : F.SSQ2};
            pg8::gemm_phase<EpiOut, pg8::StaticOrder, true, true>(F.lds, F.misc, g, S, E);
            REP_BAR(5);
        } SEAM(p + 4);
        if (PROBE_CLK && l == 0 && opaque_tid() == 0) { LAS unsigned long long* cp = (LAS unsigned long long*)(lds_ + LDSCTL_OFF + 128); cp[0] = __builtin_amdgcn_s_memtime(); cp[1] = __builtin_amdgcn_s_memrealtime(); }
        if (IN(p + 5)) for (int rep = 0; rep < REPS(6); ++rep) { MKFRAME();
            pg8::Gemm g{F.HB, F.WGU + (size_t)l * GU * KPD, MP, GU, D, D, KPD}; pg8::StaticOrder S; S.init(MP, GU, F.G, opaque_sgpr(F.bid));
            if (PROBE_VAR == 5 && rep + 1 < REPS(6)) { S.hh_all = 0; pg8::EpiNull E0; pg8::gemm_phase<pg8::EpiNull, pg8::StaticOrder, true, true>(F.lds, F.misc, g, S, E0); S.hh_all = -1; }
            else if (PROBE_VAR == 1 && rep + 1 < REPS(6)) { pg8::EpiNull E0; pg8::gemm_phase<pg8::EpiNull, pg8::StaticOrder, true, true>(F.lds, F.misc, g, S, E0); }
            else if (PROBE_VAR >= 2 && PROBE_VAR <= 4 && rep + 1 < REPS(6)) { pg8::EpiGuT<PROBE_VAR> E2{(bf16_t*)DUMH, F.SSQ2, F.SSQS2}; pg8::gemm_phase<pg8::EpiGuT<PROBE_VAR>, pg8::StaticOrder, true, true>(F.lds, F.misc, g, S, E2); }
            else {
            pg8::EpiGu E{F.ACT, F.SSQ2, F.SSQS2};
            unsigned long long pr0_ = 0; if ((PROBE_CLK == 11 || PROBE_CLK == 13) && l == 0 && opaque_tid() == 0) pr0_ = __builtin_amdgcn_s_memrealtime();
            pg8::gemm_phase<pg8::EpiGu, pg8::StaticOrder, true, true>(F.lds, F.misc, g, S, E);
            if ((PROBE_CLK == 11 || PROBE_CLK == 13) && l == 0 && opaque_tid() == 0) { const unsigned d_ = (unsigned)(__builtin_amdgcn_s_memrealtime() - pr0_); atomicMax((unsigned*)args.ws + 8007, d_ * 256u + (unsigned)F.bid); }
            }
            if (FILL_MODE == 1) hole_fill(F, (MP / 256) * (GU / 256) - 5 * F.G, HF_GU, l, WO_DN, WI_L);
            if (FILL_MODE == 1 && l + 1 < DEPTH) hole_fill(F, (MP / 256) * (GU / 256) - 5 * F.G, HF_GU - WI_DN, l + 1, 0, WO_OUT);
            REP_BAR(6);
        }
        if (PROBE_CLK && l == 0 && opaque_tid() == 0) { const unsigned long long t1 = __builtin_amdgcn_s_memtime(), r1 = __builtin_amdgcn_s_memrealtime();
            LAS unsigned long long* cp = (LAS unsigned long long*)(lds_ + LDSCTL_OFF + 128); const unsigned long long clk_t0 = cp[0], clk_r0 = cp[1];
            const float ghz = (float)(t1 - clk_t0) / ((float)(r1 - clk_r0) * 10.0f); const unsigned dur = (unsigned)(r1 - clk_r0);
            unsigned* cw = (unsigned*)args.ws + 8000;
            atomicMax(cw + 0, dur); atomicMax(cw + 1, 100000u - dur); atomicAdd(cw + 2, dur); atomicMax(cw + 3, (unsigned)(ghz * 1000.f)); atomicMax(cw + 4, 10000u - (unsigned)(ghz * 1000.f));
            if (blockIdx.x == 0) *(LAS float*)(lds_ + LDSCTL_OFF + 64) = (PROBE_CLK == 1) ? 0.15f + (ghz - 1.0f) * 0.5f : 0.15f + (float)dur * 1e-5f; }
        SEAM(p + 5);
        if (IN(p + 6)) for (int rep = 0; rep < REPS(7); ++rep) { MKFRAME();
            const bool dm = rep + 1 < REPS(7);
            pg8::Gemm g{F.ACT, F.WDN + (size_t)l * D * KPF, MPR, D, FF, FF, KPF}; pg8::StaticOrder S; S.init(MPR, D, F.G, opaque_sgpr(F.bid));
            typedef pg8::EpiRes<true, false> EpiDown;
            EpiDown E{nullptr, F.HB, dm ? DUMH : F.H, dm ? DUMHB : F.HB, dm ? DUMSSQ : F.SSQ1};
            pg8::gemm_phase<EpiDown, pg8::StaticOrder, true, true>(F.lds, F.misc, g, S, E);
            for (int rp = 0; rp < (PROBE_UNIT == 10 ? 2 : 1); ++rp)
            for (int j = F.bid; j < 256; j += F.G)
                skinny_splitk_piece<FF / 8>(F.lds, F.ACT + (size_t)MPR * FF, FF, F.WDN + (size_t)l * D * KPF, KPF, j, F.SPART);
            __syncthreads();
            REP_BAR(7);
        } SEAM(p + 6);
}

__global__ void __launch_bounds__(512, 2) mk_fwd(Args args) {
    extern __shared__ __attribute__((aligned(16))) unsigned char lds[];
    float* DUMH; bf16_t* DUMHB; float* DUMSSQ;
    unsigned char* const ws = args.ws; LAS unsigned char* const lds_ = (LAS unsigned char*)lds;
    for (int u = threadIdx.x; u < (LDS_BYTES - LDSCTL_OFF) / 4; u += 512) ((LAS unsigned*)(lds_ + LDSCTL_OFF))[u] = 0u;
    __syncthreads();
    XcdBarrier bar; bar.bar = (unsigned*)(ws + WS_CTL) + CW_BAR; bar.x = 0; bar.st = nullptr;
    if (MK_N_LAUNCHES == 1) bar = xcd_barrier_post((unsigned*)(ws + WS_CTL) + CW_BAR, (volatile LAS unsigned*)(lds_ + LDSCTL_OFF));
    const int lo = args.ph_lo, hi = args.ph_hi;

    if (IN(0)) for (int rep = 0; rep < REPS(0); ++rep) { MKFRAME(); p0_prologue(F); REP_BAR(0); } SEAM(0);
    run_layer<0>(args, lds_, bar, lo, hi);
    run_layer<1>(args, lds_, bar, lo, hi);
    static_assert(DEPTH == 2, "two layers written out");
    if (IN(N_PHASES - 1)) for (int rep = 0; rep < REPS(8); ++rep) { MKFRAME(); final_norm(F); REP_BAR(8); }
    if (PROBE_CLK && blockIdx.x == 0 && opaque_tid() == 0) { asm volatile("s_waitcnt vmcnt(0)" ::: "memory"); const unsigned* cw = (const unsigned*)args.ws + 8000; float v = *(LAS float*)(lds_ + LDSCTL_OFF + 64);
        if (PROBE_CLK == 3) v = 0.15f + (float)__hip_atomic_load(cw + 0, __ATOMIC_RELAXED, __HIP_MEMORY_SCOPE_AGENT) * 1e-5f;
        if (PROBE_CLK == 4) v = 0.15f + (float)(100000u - __hip_atomic_load(cw + 1, __ATOMIC_RELAXED, __HIP_MEMORY_SCOPE_AGENT)) * 1e-5f;
        if (PROBE_CLK == 5) v = 0.15f + (float)__hip_atomic_load(cw + 2, __ATOMIC_RELAXED, __HIP_MEMORY_SCOPE_AGENT) * (1e-5f / 256.f);
        if (PROBE_CLK == 8) v = 0.15f + (float)__hip_atomic_load(cw + 5, __ATOMIC_RELAXED, __HIP_MEMORY_SCOPE_AGENT) * 1e-4f;
        if (PROBE_CLK == 9) v = 0.15f + (float)(100000u - __hip_atomic_load(cw + 6, __ATOMIC_RELAXED, __HIP_MEMORY_SCOPE_AGENT)) * 1e-4f;
        if (PROBE_CLK == 10 || PROBE_CLK == 11) v = 0.15f + (float)(__hip_atomic_load(cw + 7, __ATOMIC_RELAXED, __HIP_MEMORY_SCOPE_AGENT) & 255u) * 0.003f;
        if (PROBE_CLK == 12 || PROBE_CLK == 13) v = 0.15f + (float)(__hip_atomic_load(cw + 7, __ATOMIC_RELAXED, __HIP_MEMORY_SCOPE_AGENT) >> 8) * 1e-5f;
        if (PROBE_CLK == 6) v = 0.15f + ((float)__hip_atomic_load(cw + 3, __ATOMIC_RELAXED, __HIP_MEMORY_SCOPE_AGENT) * 1e-3f - 1.0f) * 0.5f;
        if (PROBE_CLK == 7) v = 0.15f + ((float)(10000u - __hip_atomic_load(cw + 4, __ATOMIC_RELAXED, __HIP_MEMORY_SCOPE_AGENT)) * 1e-3f - 1.0f) * 0.5f;
        args.out[O_YS] += v; }
#undef REPS
#undef REP_BAR
#undef MKFRAME
#undef IN
#undef SEAM
}

extern "C" void kernel_launch(void* const* d_in, const int* in_sizes, int n_in, void* d_out, int out_size, void* d_ws, size_t ws_size, hipStream_t stream) {
    static int grid = 0;
    if (grid == 0) {
        if (n_in != 19 || (size_t)out_size != O_END || ws_size < WS_END) { fprintf(stderr, "kernel_launch: unexpected sizes (n_in %d, out %d, ws %zu)\n", n_in, out_size, ws_size); grid = -1; return; }
        int dev = 0, cus = 0, per_cu = 0;
        if (hipGetDevice(&dev) != hipSuccess || hipDeviceGetAttribute(&cus, hipDeviceAttributeMultiprocessorCount, dev) != hipSuccess) { grid = -1; return; }
        if (hipFuncSetAttribute((const void*)mk_fwd, hipFuncAttributeMaxDynamicSharedMemorySize, LDS_BYTES) != hipSuccess) { fprintf(stderr, "kernel_launch: hipFuncSetAttribute failed\n"); grid = -1; return; }
        if (hipOccupancyMaxActiveBlocksPerMultiprocessor(&per_cu, (const void*)mk_fwd, 512, LDS_BYTES) != hipSuccess || per_cu < 1) { fprintf(stderr, "kernel_launch: occupancy query says %d blocks per CU\n", per_cu); per_cu = 1; }
        (void)hipGetLastError();
        grid = cus;
    }
    if (grid < 0) return;
    (void)hipMemsetAsync((char*)d_ws + WS_CTL, 0, CTL_ZERO_BYTES, stream);
    Args a{};
    for (int i = 0; i < 19; ++i) a.in[i] = (const float*)d_in[i];
    a.out = (float*)d_out; a.ws = (unsigned char*)d_ws;
    if (MK_N_LAUNCHES == 1) { a.ph_lo = 0; a.ph_hi = N_PHASES; a.li = 0; hipLaunchKernelGGL(mk_fwd, dim3(grid), dim3(512), LDS_BYTES, stream, a); }
    else for (int li = 0; li < N_PHASES; ++li) { a.ph_lo = li; a.ph_hi = li + 1; a.li = li; hipLaunchKernelGGL(mk_fwd, dim3(grid), dim3(512), LDS_BYTES, stream, a); }
}
```

```cpp
#include <hip/hip_runtime.h>
#include <cstdio>
#include <cstdint>

#ifndef MK_N_LAUNCHES
#define MK_N_LAUNCHES 1
#endif

#ifndef PROBE_CLK
#define PROBE_CLK 0
#endif
#ifndef PROBE_UNIT
#define PROBE_UNIT 0
#endif
#ifndef PROBE_SEAM
#define PROBE_SEAM (-1)
#endif
#ifndef FILL_MODE
#define FILL_MODE 1
#endif
#ifndef PROBE_XBAR
#define PROBE_XBAR 0
#endif
#ifndef PROBE_VAR
#define PROBE_VAR 0
#endif
#ifndef PROBE_DUP
#define PROBE_DUP (-1)
#endif
#define LAS __attribute__((address_space(3)))
#define GAS __attribute__((address_space(1)))
#define DI __device__ __forceinline__

typedef unsigned short bf16_t;
typedef short bf16x8 __attribute__((ext_vector_type(8)));
typedef short s16x4 __attribute__((ext_vector_type(4)));
typedef float f32x4 __attribute__((ext_vector_type(4)));
typedef float f32x2 __attribute__((ext_vector_type(2)));
typedef unsigned u32x4 __attribute__((ext_vector_type(4)));
typedef unsigned u32x2 __attribute__((ext_vector_type(2)));
typedef __bf16 bf16x2_t __attribute__((ext_vector_type(2)));

constexpr int D = 2048, INW = 5120, FF = 5632, GU = 2 * FF;
constexpr int NB = 4, SEQ = 2048, MPR = NB * SEQ  , NS = 128, MV = MPR + NS  , MP = 8448  ;
constexpr int DEPTH = 2, NCH = SEQ / 128  ;
constexpr int C_A = 0, C_BG = 512, C_CG = 1024, C_HH = 1536, C_Q = 2048, C_K = 2560, C_V = 3072, C_G = 3584, C_U = 4096, C_VV = 4608;
constexpr float NORM_EPS = 1e-6f;
#ifndef WPAD
#define WPAD 0
#endif
constexpr int KPD = D + WPAD, KPF = FF + WPAD;
constexpr int ROPE_SPOS = 2048;
constexpr size_t O_YP = 0, O_YS = 16777216, O_POOLP = 17039360, O_POOLS = 17100800, O_CONVP = 19066880, O_CONVS = 19075072,
                 O_RETP = 19337216, O_RETS = 19861504, O_SGUP = 36638720, O_SGUS = 37163008, O_END = 37294080;

constexpr size_t MiB = 1u << 20;
constexpr size_t WS_CTL = 0, CTL_ZERO_BYTES = 1 * MiB;
constexpr size_t WS_ROPE = 1 * MiB;
constexpr size_t WS_POOLW = 3 * MiB;
constexpr size_t WS_SGUW = 4 * MiB;
constexpr size_t WS_SSQ1 = 5 * MiB, WS_SSQ2 = 6 * MiB;
constexpr size_t WS_SSQS1 = 7 * MiB, WS_SSQS2 = 7 * MiB + 65536;
constexpr size_t WS_WIN = 8 * MiB;
constexpr size_t WS_WOUT = 52 * MiB;
constexpr size_t WS_WGU = 70 * MiB;
constexpr size_t WS_WDN = 162 * MiB;
constexpr size_t WS_H = 208 * MiB;
constexpr size_t WS_HB = 274 * MiB;
constexpr size_t WS_PB = 310 * MiB;
constexpr size_t WS_MIX = 394 * MiB;
constexpr size_t WS_ACT = 430 * MiB;
constexpr size_t WS_KV = 523 * MiB;
constexpr size_t WS_SB = 540 * MiB;
constexpr size_t WS_SPART = 548 * MiB;
constexpr size_t WS_DUMH = 556 * MiB, WS_DUMHB = 622 * MiB, WS_DUMSSQ = 658 * MiB;
constexpr size_t WS_END = 660 * MiB;
static_assert(WS_WIN + (size_t)2 * INW * KPD * 2 <= WS_WOUT && WS_WOUT + (size_t)2 * D * KPD * 2 <= WS_WGU && WS_WGU + (size_t)2 * GU * KPD * 2 <= WS_WDN && WS_WDN + (size_t)2 * D * KPF * 2 <= WS_H, "weight buffers");
constexpr int CW_BAR = 4096;
constexpr int CW_SGATE = 8192;
constexpr int CW_FILL = 8704;

constexpr int RING_BYTES = 131072;
constexpr int MISC_OFF = RING_BYTES;
constexpr int LDSCTL_OFF = MISC_OFF + 4096;
constexpr int LDS_BYTES = 147456;

DI float bf2f(unsigned short b) { return __uint_as_float(((unsigned)b) << 16); }
DI float bflo(unsigned w) { return __uint_as_float(w << 16); }
DI float bfhi(unsigned w) { return __uint_as_float(w & 0xffff0000u); }
DI unsigned pk2(float lo, float hi) { f32x2 v = {lo, hi}; bf16x2_t b = __builtin_convertvector(v, bf16x2_t); return __builtin_bit_cast(unsigned, b); }
DI float wave_sum(float v) {
#pragma unroll
    for (int o = 1; o < 64; o <<= 1) v += __shfl_xor(v, o);
    return v;
}
DI float silu_f(float g) { return g * __builtin_amdgcn_rcpf(1.0f + __builtin_amdgcn_exp2f(g * -1.4426950408889634f)); }
DI float silu_fast(float g) { return silu_f(g); }
DI int opaque_sgpr(int v) { asm volatile("" : "+s"(v)); return v; }
DI int opaque_tid() { int t = threadIdx.x; asm volatile("" : "+v"(t)); return t; }

namespace pg8 {
constexpr int BM = 256, BK = 64, HALF = 128, HTB = HALF * BK * 2  , STAGE_BYTES = 8 * HTB, NXCD = 8, WGM = 8;
#ifndef PG8_LINE128
#define PG8_LINE128 true
#endif
constexpr bool LINE128 = PG8_LINE128;
__host__ __device__ __forceinline__ int lds_byte(int r, int c) { const int st = (r >> 4) * 2 + (c >> 5), rr = r & 15, cc = c & 31, ob = rr * 64 + cc * 2; return st * 1024 + (ob ^ (((ob >> 9) & 1) << 5)); }
__host__ __device__ __forceinline__ void stage_rc(int b, int& R, int& C) { const int st = b / 1024, sb = b % 1024, swz = sb ^ (((sb >> 9) & 1) << 5); R = (st >> 1) * 16 + swz / 64; C = (st & 1) * 32 + (swz % 64) / 2; }
__host__ __device__ __forceinline__ int perm32(int rho) { const int n = rho >> 4, i = rho & 15; return 8 * (i >> 2) + 4 * n + (i & 3); }

struct Unit { int pm, pn, hh; };
struct Gemm { const bf16_t* A; const bf16_t* Bt; int M, N, K, lda, ldb; };

struct StaticOrder {
    int nM, nN, nwg, G, c;
    __host__ __device__ void init(int M, int N, int G_, int c_) { nM = M / BM; nN = N / BM; nwg = nM * nN; G = G_; c = c_; }
    __host__ __device__ bool next(int i, Unit& u) const {
        const long L = (long)i * G + c; if (L >= nwg) return false;
        int wgid = (int)L; { const int q = nwg / NXCD, r = nwg % NXCD, xcd = wgid % NXCD, off = wgid / NXCD; wgid = (xcd < r ? xcd * (q + 1) : r * (q + 1) + (xcd - r) * q) + off; }
        const int nig = WGM * nN, gid = wgid / nig, fm = gid * WGM, gsz = (nM - fm) < WGM ? (nM - fm) : WGM;
        u.pm = fm + ((wgid % nig) % gsz); u.pn = (wgid % nig) / gsz; u.hh = hh_all; return true;
    }
    __device__ __forceinline__ void a_ready(const Unit&) const {}
    __device__ __forceinline__ void done(const Unit&) const {}
    int hh_all = -1;
};

struct GatedOrder : StaticOrder {
    unsigned* cnt; unsigned need;
    __device__ __forceinline__ void a_ready(const Unit& u) const {
        if (u.pm * BM >= MPR) {
            if (opaque_tid() < 64) { unsigned sp = 0;
                while ((unsigned)__builtin_amdgcn_readfirstlane(__hip_atomic_load(cnt, __ATOMIC_RELAXED, __HIP_MEMORY_SCOPE_AGENT)) < need) { __builtin_amdgcn_s_sleep(2); if (++sp > (1u << 22)) break; }
                __builtin_amdgcn_fence(__ATOMIC_ACQUIRE, "agent");
                asm volatile("s_waitcnt vmcnt(0)" ::: "memory"); }
            asm volatile("" ::: "memory"); __builtin_amdgcn_s_barrier(); asm volatile("" ::: "memory");
        }
    }
};

DI float row_rstd(const float* ssq, const float* ssqs, int row) {
    float ss;
    if (row < MPR) { const f32x4 s0 = *(const f32x4*)(ssq + (size_t)row * 8), s1 = *(const f32x4*)(ssq + (size_t)row * 8 + 4);
        ss = ((s0[0] + s0[1]) + (s0[2] + s0[3])) + ((s1[0] + s1[1]) + (s1[2] + s1[3])); }
    else { const f32x4* p = (const f32x4*)(ssqs + (size_t)(row - MPR) * 128); f32x4 a = p[0];
#pragma unroll
        for (int i = 1; i < 32; ++i) a += p[i];
        ss = (a[0] + a[1]) + (a[2] + a[3]); }
    return __builtin_amdgcn_rsqf(ss * (1.0f / (float)D) + NORM_EPS);
}
DI void tile_rstd(const float* ssq, const float* ssqs, int pm, int row0, float (&rs)[2][4], LAS unsigned char* misc, int tid) {
    if (pm * BM < MPR) {
        f32x4 a[2][4], b[2][4];
#pragma unroll
        for (int ai = 0; ai < 2; ++ai)
#pragma unroll
            for (int m = 0; m < 4; ++m) { const float* p = ssq + (size_t)(row0 + ai * HALF + m * 16) * 8; a[ai][m] = *(const f32x4*)p; b[ai][m] = *(const f32x4*)(p + 4); }
#pragma unroll
        for (int ai = 0; ai < 2; ++ai)
#pragma unroll
            for (int m = 0; m < 4; ++m) { const f32x4 t = a[ai][m] + b[ai][m]; rs[ai][m] = __builtin_amdgcn_rsqf(((t[0] + t[1]) + (t[2] + t[3])) * (1.0f / (float)D) + NORM_EPS); }
    } else {
        LAS float* tab = (LAS float*)misc;
        { const f32x4* p = (const f32x4*)(ssqs + (size_t)(tid >> 2) * 128 + (tid & 3) * 32); f32x4 t = p[0];
#pragma unroll
          for (int i = 1; i < 8; ++i) t += p[i];
          float ss = (t[0] + t[1]) + (t[2] + t[3]); ss += __shfl_xor(ss, 1); ss += __shfl_xor(ss, 2);
          if ((tid & 3) == 0) tab[tid >> 2] = __builtin_amdgcn_rsqf(ss * (1.0f / (float)D) + NORM_EPS); }
        asm volatile("s_waitcnt lgkmcnt(0)" ::: "memory"); __builtin_amdgcn_s_barrier(); asm volatile("" ::: "memory");
#pragma unroll
        for (int m = 0; m < 4; ++m) { const int r = row0 + m * 16 - MPR; rs[0][m] = (r < NS) ? tab[r] : 0.f; rs[1][m] = 0.f; }
    }
}
struct EpiIn {
    static constexpr bool PERM = true;
    bf16_t* P; const float* ssq; const float* ssqs;
    DI void operator()(const f32x4 (&acc)[2][2][4][2], const Unit& u, int wr, int wc, int fr, int fq, LAS unsigned char* misc, int tid) const {
        tid = opaque_tid(); fr = tid & 15; fq = (tid >> 4) & 3;
        const int row0 = u.pm * BM + wr * 64 + fr, col0 = u.pn * BM + wc * 32 + 8 * fq;
        float rsv[2][4]; tile_rstd(ssq, ssqs, u.pm, row0, rsv, misc, tid);
#pragma unroll
        for (int ai = 0; ai < 2; ++ai)
#pragma unroll
            for (int m = 0; m < 4; ++m) { const int row = row0 + ai * HALF + m * 16;
                if (row < MV) { const float rs = rsv[ai][m]; bf16_t* rowp = P + (size_t)row * INW + col0;
#pragma unroll
                    for (int bj = 0; bj < 2; ++bj) { const f32x4 v0 = acc[ai][bj][m][0] * rs, v1 = acc[ai][bj][m][1] * rs;
                        u32x4 w; w.x = pk2(v0[0], v0[1]); w.y = pk2(v0[2], v0[3]); w.z = pk2(v1[0], v1[1]); w.w = pk2(v1[2], v1[3]);
                        *(u32x4*)(rowp + bj * HALF) = w; } } }
    }
};
template <int VAR>
struct EpiGuT {
    static constexpr bool PERM = true;
    bf16_t* ACT; const float* ssq; const float* ssqs;
    DI void operator()(const f32x4 (&acc)[2][2][4][2], const Unit& u, int wr, int wc, int fr, int fq, LAS unsigned char* misc, int tid) const {
        tid = opaque_tid(); fr = tid & 15; fq = (tid >> 4) & 3;
        const int row0 = u.pm * BM + wr * 64 + fr, col0 = u.pn * HALF + wc * 32 + 8 * fq;
        float rsv[2][4]; tile_rstd(ssq, ssqs, u.pm, row0, rsv, misc, tid);
#pragma unroll
        for (int ai = 0; ai < 2; ++ai)
#pragma unroll
            for (int m = 0; m < 4; ++m) { const int row = row0 + ai * HALF + m * 16;
                if (row < MV) { const float rs = rsv[ai][m];
                    float o[8];
#pragma unroll
                    for (int n = 0; n < 2; ++n)
#pragma unroll
                        for (int j = 0; j < 4; ++j) { const float g = acc[ai][0][m][n][j] * rs, up = acc[ai][1][m][n][j] * rs;
                            o[n * 4 + j] = (VAR == 3) ? g + up : (VAR == 4) ? silu_fast(g) * up : silu_f(g) * up; }
                    u32x4 w; w.x = pk2(o[0], o[1]); w.y = pk2(o[2], o[3]); w.z = pk2(o[4], o[5]); w.w = pk2(o[6], o[7]);
                    if (VAR == 2) asm volatile("" :: "v"(w)); else *(u32x4*)(ACT + (size_t)row * FF + col0) = w; } }
    }
};
typedef EpiGuT<0> EpiGu;
struct EpiNull {
    static constexpr bool PERM = true;
    DI void operator()(const f32x4 (&acc)[2][2][4][2], const Unit&, int, int, int, int, LAS unsigned char*, int) const {
#pragma unroll
        for (int ai = 0; ai < 2; ++ai)
#pragma unroll
            for (int bj = 0; bj < 2; ++bj)
#pragma unroll
                for (int m = 0; m < 4; ++m)
#pragma unroll
                    for (int n = 0; n < 2; ++n) asm volatile("" :: "v"(acc[ai][bj][m][n]));
    }
};
template <bool BASE_BF16, bool OUT_F32>
struct EpiRes {
    static constexpr bool PERM = true;
    const float* base_f; const bf16_t* base_b;
    float* H; bf16_t* HB; float* ssq_out;
    DI void operator()(const f32x4 (&acc)[2][2][4][2], const Unit& u, int wr, int wc, int fr, int fq, LAS unsigned char* misc, int tid) const {
        tid = opaque_tid(); fr = tid & 15; fq = (tid >> 4) & 3;
        LAS float* part = (LAS float*)misc;
        const int col0 = u.pn * BM + wc * 32 + 8 * fq;
#pragma unroll
        for (int ai = 0; ai < 2; ++ai)
#pragma unroll
          for (int mh = 0; mh < 2; ++mh) {
            f32x4 bb[2][2][2];
#pragma unroll
            for (int mm = 0; mm < 2; ++mm) { const size_t off = (size_t)(u.pm * BM + ai * HALF + wr * 64 + (2 * mh + mm) * 16 + fr) * D + col0;
#pragma unroll
                for (int bj = 0; bj < 2; ++bj) {
                    if (BASE_BF16) { const u32x4 w = *(const u32x4*)(base_b + off + bj * HALF);
                        bb[mm][bj][0] = (f32x4){bflo(w.x), bfhi(w.x), bflo(w.y), bfhi(w.y)}; bb[mm][bj][1] = (f32x4){bflo(w.z), bfhi(w.z), bflo(w.w), bfhi(w.w)}; }
                    else { bb[mm][bj][0] = *(const f32x4*)(base_f + off + bj * HALF); bb[mm][bj][1] = *(const f32x4*)(base_f + off + bj * HALF + 4); } } }
#pragma unroll
            for (int mm = 0; mm < 2; ++mm) { const int m = 2 * mh + mm; const int rl = ai * HALF + wr * 64 + m * 16 + fr, row = u.pm * BM + rl; float ss = 0.f;
                { const size_t off = (size_t)row * D + col0;
#pragma unroll
                    for (int bj = 0; bj < 2; ++bj) { const f32x4 b0 = bb[mm][bj][0], b1 = bb[mm][bj][1];
                        const f32x4 h0 = b0 + acc[ai][bj][m][0], h1 = b1 + acc[ai][bj][m][1];
                        if (OUT_F32) { *(f32x4*)(H + off + bj * HALF) = h0; *(f32x4*)(H + off + bj * HALF + 4) = h1; }
                        else { u32x4 w; w.x = pk2(h0[0], h0[1]); w.y = pk2(h0[2], h0[3]); w.z = pk2(h1[0], h1[1]); w.w = pk2(h1[2], h1[3]);
                            *(u32x4*)(HB + off + bj * HALF) = w; }
                        ss += ((h0[0] * h0[0] + h0[1] * h0[1]) + (h0[2] * h0[2] + h0[3] * h0[3])) + ((h1[0] * h1[0] + h1[1] * h1[1]) + (h1[2] * h1[2] + h1[3] * h1[3])); } }
                ss += __shfl_xor(ss, 16); ss += __shfl_xor(ss, 32);
                if (fq == 0) part[rl * 4 + wc] = ss; } }
        asm volatile("s_waitcnt lgkmcnt(0)" ::: "memory"); __builtin_amdgcn_s_barrier(); asm volatile("" ::: "memory");
        float* so = ssq_out; asm volatile("" : "+v"(so));
        if (tid < 256) { const int row = u.pm * BM + tid; const LAS f32x4* p4 = (const LAS f32x4*)(part + tid * 4); const f32x4 p = *p4;
            __hip_atomic_store(so + (size_t)row * 8 + u.pn, (p[0] + p[1]) + (p[2] + p[3]), __ATOMIC_RELAXED, __HIP_MEMORY_SCOPE_AGENT); }
    }
};

template <class Epi, class Sched, bool ALIGN_EPI, bool SP2>
__device__ __forceinline__ void gemm_phase(LAS unsigned char* lds, LAS unsigned char* misc, const Gemm g, const Sched& S, const Epi& E) {
    const int tid = opaque_tid(), wid = __builtin_amdgcn_readfirstlane(tid >> 6), lane = tid & 63, wr = wid >> 2, wc = wid & 3, fr = lane & 15, fq = lane >> 4;
    const int K = g.K, nt = K / BK;
    unsigned voffA[2], voffB[2];
#pragma unroll
    for (int i = 0; i < 2; ++i) { int R, C; const int Bb = tid * 16 + i * 8192;
        if (LINE128) { R = Bb >> 7; C = ((((Bb >> 4) & 7) ^ (R & 7)) << 3); } else stage_rc(Bb, R, C);
        const int Rb = Epi::PERM ? ((R & ~31) + perm32(R & 31)) : R;
        voffA[i] = (unsigned)(R * g.lda + C) * 2u; voffB[i] = (unsigned)(Rb * g.ldb + C) * 2u; }
    const size_t kstep = (size_t)(BK * 2);
    const size_t hstep = (size_t)HALF * g.lda * 2, hstepB = (size_t)HALF * g.ldb * 2;
    const size_t tstep = 2 * hstep, tstepB = 2 * hstepB;
    const unsigned ldsw = (unsigned)wid * 1024u;
    int aoffk[2], boffk[2];
#pragma unroll
    for (int k = 0; k < 2; ++k) {
        if (LINE128) { aoffk[k] = (wr * 64 + fr) * 128 + ((((4 * k + fq) ^ (fr & 7))) << 4); boffk[k] = (wc * 32 + fr) * 128 + ((((4 * k + fq) ^ (fr & 7))) << 4); }
        else { aoffk[k] = lds_byte(wr * 64 + fr, fq * 8) + k * 1024; boffk[k] = lds_byte(wc * 32 + fr, fq * 8) + k * 1024; } }
#define PG8_SA(b, h) (((b) * 2 + (h)) * HTB)
#define PG8_SB(b, h) ((4 + (b) * 2 + (h)) * HTB)
#define PG8_STAGE(bufoff, gbase, voff) do { _Pragma("unroll") for (int _i = 0; _i < 2; ++_i) \
        __builtin_amdgcn_global_load_lds((const unsigned*)((const char*)(gbase) + (voff)[_i]), (LAS unsigned*)(lds + (bufoff) + ldsw + _i * 8192), 16, 0, 0); } while (0)
#define PG8_LDA(dst, b, h) do { _Pragma("unroll") for (int m = 0; m < 4; ++m) _Pragma("unroll") for (int k = 0; k < 2; ++k) dst[m][k] = *(const LAS bf16x8*)(lds + PG8_SA(b, h) + aoffk[k] + m * 2048); } while (0)
#define PG8_LDB(dst, b, h) do { _Pragma("unroll") for (int n = 0; n < 2; ++n) _Pragma("unroll") for (int k = 0; k < 2; ++k) dst[n][k] = *(const LAS bf16x8*)(lds + PG8_SB(b, h) + boffk[k] + n * 2048); } while (0)
#define PG8_MMA(ai, bj, At, Bt) do { __builtin_amdgcn_s_setprio(1); _Pragma("unroll") for (int m = 0; m < 4; ++m) _Pragma("unroll") for (int n = 0; n < 2; ++n) _Pragma("unroll") for (int k = 0; k < 2; ++k) \
        acc[ai][bj][m][n] = __builtin_amdgcn_mfma_f32_16x16x32_bf16(Bt[n][k], At[m][k], acc[ai][bj][m][n], 0, 0, 0); __builtin_amdgcn_s_setprio(0); } while (0)
#define PG8_WAIT_V(n) asm volatile("s_waitcnt vmcnt(" #n ")" ::: "memory")
#define PG8_WAIT_L(n) asm volatile("s_waitcnt lgkmcnt(" #n ")" ::: "memory")
#define PG8_BAR __builtin_amdgcn_s_barrier()
#define PG8_SCHED __builtin_amdgcn_sched_barrier(0)
    Unit cur, nxt; int ui = 0;
    if (!S.next(0, cur)) return;
    f32x4 acc[2][2][4][2];
#pragma unroll
    for (int a = 0; a < 2; ++a)
#pragma unroll
        for (int b = 0; b < 2; ++b)
#pragma unroll
            for (int m = 0; m < 4; ++m)
#pragma unroll
                for (int n = 0; n < 2; ++n) acc[a][b][m][n] = (f32x4){0.f, 0.f, 0.f, 0.f};
    bf16x8 At[4][2], B0[2][2], B1[2][2];
    const char* cA = (const char*)g.A + (size_t)cur.pm * tstep; const char* cB = (const char*)g.Bt + (size_t)cur.pn * tstepB;
    S.a_ready(cur);
    if constexpr (SP2) {
        PG8_STAGE(PG8_SB(0, 0), cB, voffB); PG8_STAGE(PG8_SB(0, 1), cB + hstepB, voffB); PG8_STAGE(PG8_SA(0, 0), cA, voffA); PG8_STAGE(PG8_SA(0, 1), cA + hstep, voffA);
        if (wr == 1) PG8_BAR;
        PG8_WAIT_V(2); PG8_BAR;
        PG8_STAGE(PG8_SB(1, 0), cB + kstep, voffB); PG8_STAGE(PG8_SA(1, 0), cA + kstep, voffA); PG8_STAGE(PG8_SB(1, 1), cB + hstepB + kstep, voffB);
        PG8_WAIT_V(6); PG8_BAR;
    } else {
        PG8_STAGE(PG8_SB(0, 0), cB, voffB); PG8_STAGE(PG8_SA(0, 0), cA, voffA); PG8_STAGE(PG8_SB(0, 1), cB + hstepB, voffB); PG8_STAGE(PG8_SA(0, 1), cA + hstep, voffA);
        if (wr == 1) PG8_BAR;
        PG8_WAIT_V(4); PG8_BAR;
        PG8_STAGE(PG8_SB(1, 0), cB + kstep, voffB); PG8_STAGE(PG8_SA(1, 0), cA + kstep, voffA); PG8_STAGE(PG8_SB(1, 1), cB + hstepB + kstep, voffB);
        PG8_WAIT_V(6); PG8_BAR;
    }
    for (;;) {
        const bool has_next = S.next(ui + 1, nxt);
        const char* nA = has_next ? (const char*)g.A + (size_t)nxt.pm * tstep : cA; const char* nB = has_next ? (const char*)g.Bt + (size_t)nxt.pn * tstepB : cB;
        for (int t = 0; t < nt; t += 2) {
            const bool last = (t == nt - 2);
            const char* a1 = cA + (size_t)(t + 1) * kstep;
            const char* a2 = last ? nA : cA + (size_t)(t + 2) * kstep; const char* b2 = last ? nB : cB + (size_t)(t + 2) * kstep;
            const char* a3 = a2 + kstep; const char* b3 = b2 + kstep;
            if (last && has_next) S.a_ready(nxt);
            if constexpr (SP2) {
            const bool chalf = (PROBE_DUP >= 0) && cur.hh >= 0;
            PG8_LDB(B0, 0, 0); PG8_LDB(B1, 0, 1); PG8_SCHED; PG8_LDA(At, 0, 0); PG8_STAGE(PG8_SA(1, 1), a1 + hstep, voffA);
            PG8_WAIT_V(8); PG8_WAIT_L(0); PG8_BAR; PG8_MMA(0, 0, At, B0); PG8_MMA(0, 1, At, B1); PG8_BAR; PG8_SCHED;
            if (!chalf) PG8_LDA(At, 0, 1);
            PG8_STAGE(PG8_SB(0, 0), b2, voffB); PG8_STAGE(PG8_SB(0, 1), b2 + hstepB, voffB); PG8_STAGE(PG8_SA(0, 0), a2, voffA);
            PG8_WAIT_V(8); PG8_WAIT_L(0); PG8_BAR; if (!chalf) { PG8_MMA(1, 0, At, B0); PG8_MMA(1, 1, At, B1); } PG8_BAR; PG8_SCHED;
            PG8_LDB(B0, 1, 0); PG8_LDB(B1, 1, 1); PG8_SCHED; PG8_LDA(At, 1, 0); PG8_STAGE(PG8_SA(0, 1), a2 + hstep, voffA);
            PG8_WAIT_V(8); PG8_WAIT_L(0); PG8_BAR; PG8_MMA(0, 0, At, B0); PG8_MMA(0, 1, At, B1); PG8_BAR; PG8_SCHED;
            if (!chalf) PG8_LDA(At, 1, 1);
            PG8_STAGE(PG8_SB(1, 0), b3, voffB); PG8_STAGE(PG8_SB(1, 1), b3 + hstepB, voffB); PG8_STAGE(PG8_SA(1, 0), a3, voffA);
            PG8_WAIT_V(8); PG8_WAIT_L(0); PG8_BAR; if (!chalf) { PG8_MMA(1, 0, At, B0); PG8_MMA(1, 1, At, B1); } PG8_BAR; PG8_SCHED;
            } else {
            PG8_LDB(B0, 0, 0); PG8_SCHED; PG8_LDA(At, 0, 0); PG8_STAGE(PG8_SA(1, 1), a1 + hstep, voffA);
            PG8_WAIT_L(8); PG8_BAR; PG8_WAIT_L(0); PG8_MMA(0, 0, At, B0); PG8_BAR; PG8_SCHED;
            PG8_LDB(B1, 0, 1); PG8_STAGE(PG8_SB(0, 0), b2, voffB);
            PG8_BAR; PG8_WAIT_L(0); PG8_MMA(0, 1, At, B1); PG8_BAR;
            PG8_LDA(At, 0, 1); PG8_STAGE(PG8_SA(0, 0), a2, voffA);
            PG8_BAR; PG8_WAIT_L(0); PG8_MMA(1, 0, At, B0); PG8_BAR; PG8_SCHED;
            PG8_STAGE(PG8_SB(0, 1), b2 + hstepB, voffB);
            PG8_WAIT_V(6); PG8_BAR; PG8_MMA(1, 1, At, B1); PG8_BAR;
            PG8_LDB(B0, 1, 0); PG8_SCHED; PG8_LDA(At, 1, 0); PG8_STAGE(PG8_SA(0, 1), a2 + hstep, voffA);
            PG8_WAIT_L(8); PG8_BAR; PG8_WAIT_L(0); PG8_MMA(0, 0, At, B0); PG8_BAR; PG8_SCHED;
            PG8_LDB(B1, 1, 1); PG8_STAGE(PG8_SB(1, 0), b3, voffB);
            PG8_BAR; PG8_WAIT_L(0); PG8_MMA(0, 1, At, B1); PG8_BAR;
            PG8_LDA(At, 1, 1); PG8_STAGE(PG8_SA(1, 0), a3, voffA);
            PG8_BAR; PG8_WAIT_L(0); PG8_MMA(1, 0, At, B0); PG8_BAR; PG8_SCHED;
            PG8_STAGE(PG8_SB(1, 1), b3 + hstepB, voffB);
            PG8_WAIT_V(6); PG8_BAR; PG8_MMA(1, 1, At, B1); PG8_BAR;
            }
        }
        if constexpr (ALIGN_EPI) { if (wr == 0) PG8_BAR; }
        E(acc, cur, wr, wc, 0, 0, misc, 0); S.done(cur);
        if (!has_next) break;
#pragma unroll
        for (int a = 0; a < 2; ++a)
#pragma unroll
            for (int b = 0; b < 2; ++b)
#pragma unroll
                for (int m = 0; m < 4; ++m)
#pragma unroll
                    for (int n = 0; n < 2; ++n) acc[a][b][m][n] = (f32x4){0.f, 0.f, 0.f, 0.f};
        cur = nxt; cA = nA; cB = nB; ++ui;
        if constexpr (ALIGN_EPI) { if (wr == 1) PG8_BAR; }
    }
    PG8_WAIT_V(0);
    if constexpr (!ALIGN_EPI) { if (wr == 0) PG8_BAR; }
    PG8_BAR;
#undef PG8_SA
#undef PG8_SB
#undef PG8_STAGE
#undef PG8_LDA
#undef PG8_LDB
#undef PG8_MMA
#undef PG8_WAIT_V
#undef PG8_WAIT_L
#undef PG8_BAR
#undef PG8_SCHED
}
}

#define XB_TMO      128
#define XB_XCNT(j)  (256  + 64 * (j))
#define XB_XSUB(j)  (1280 + 64 * (j))
#define XB_XGEN(j)  (2304 + 64 * (j))
#define XB_TOP      3328
#define XB_TOPGEN   3392
#define XCD_BAR_WORDS 3456
#define XB_SPIN_CAP (1u << 18)

DI unsigned xb_ld(unsigned* p)              { return __hip_atomic_load(p, __ATOMIC_RELAXED, __HIP_MEMORY_SCOPE_AGENT); }
DI unsigned xb_add(unsigned* p, unsigned v) { return __hip_atomic_fetch_add(p, v, __ATOMIC_RELAXED, __HIP_MEMORY_SCOPE_AGENT); }
DI unsigned xb_xcc_id() { return (unsigned)__builtin_amdgcn_s_getreg((3 << 11) | 20) & 0xFu; }
#define XB_SPIN(cond, bar) do { unsigned _sp = 0; while (cond) { __builtin_amdgcn_s_sleep(1); \
    if ((++_sp & 255u) == 0u) { if (xb_ld(&(bar)[XB_TMO])) break; if (_sp > XB_SPIN_CAP) { atomicAdd(&(bar)[XB_TMO], 1u); break; } } } } while (0)

struct XcdBarrier { unsigned* bar; unsigned x; volatile LAS unsigned* st; };

DI XcdBarrier xcd_barrier_post(unsigned* bar, volatile LAS unsigned* st) {
    XcdBarrier b; b.bar = bar; b.x = xb_xcc_id(); b.st = st;
    if (threadIdx.x == 0) (void)xb_add(&bar[XB_XCNT(b.x)], 1u);
    return b;
}
DI void xcd_barrier_complete(unsigned* bar, unsigned x, unsigned& nloc, unsigned& nx) {
    const unsigned G = gridDim.x * gridDim.y * gridDim.z;
    unsigned sum, cnt, mine, sp = 0u;
    for (;;) {
        sum = 0u; cnt = 0u; mine = 0u;
#pragma unroll
        for (unsigned j = 0; j < 16; ++j) { const unsigned c = xb_ld(&bar[XB_XCNT(j)]); sum += c; cnt += (c > 0u) ? 1u : 0u; mine = (j == x) ? c : mine; }
        if (sum == G) break;
        __builtin_amdgcn_s_sleep(1);
        if ((++sp & 255u) == 0u) { if (xb_ld(&bar[XB_TMO])) break; if (sp > XB_SPIN_CAP) { atomicAdd(&bar[XB_TMO], 1u); break; } }
    }
    nloc = mine > 0u ? mine : 1u; nx = cnt > 0u ? cnt : 1u;
}
DI void xcd_barrier(const XcdBarrier& b) {
    asm volatile("s_waitcnt vmcnt(0)" ::: "memory");
    __syncthreads();
    if (threadIdx.x == 0) {
        unsigned* bar = b.bar; asm volatile("" : "+s"(bar));
        __builtin_amdgcn_s_waitcnt(0);
        unsigned nloc = b.st[0], nx = b.st[1];
        if (nloc == 0u) { xcd_barrier_complete(bar, b.x, nloc, nx); b.st[0] = nloc; b.st[1] = nx; }
        const unsigned old = xb_add(&bar[XB_XSUB(b.x)], 1u);
        const unsigned gen = old / nloc;
        if (old + 1u == (gen + 1u) * nloc) {
            __builtin_amdgcn_fence(__ATOMIC_RELEASE, "agent");
            asm volatile("s_waitcnt vmcnt(0)" ::: "memory");
            const unsigned og = xb_add(&bar[XB_TOP], 1u);
            const unsigned tg = og / nx;
            if (og + 1u == (tg + 1u) * nx) xb_add(&bar[XB_TOPGEN], 1u);
            else XB_SPIN(xb_ld(&bar[XB_TOPGEN]) == tg, bar);
            __builtin_amdgcn_fence(__ATOMIC_ACQUIRE, "agent");
            xb_add(&bar[XB_XGEN(b.x)], 1u);
            asm volatile("s_waitcnt vmcnt(0)" ::: "memory");
        } else {
            XB_SPIN(xb_ld(&bar[XB_XGEN(b.x)]) == gen, bar);
            __builtin_amdgcn_fence(__ATOMIC_ACQUIRE, "agent");
            asm volatile("s_waitcnt vmcnt(0)" ::: "memory");
        }
    }
    __syncthreads();
}

struct Args {
    const float* in[19]; float* out; unsigned char* ws; int ph_lo, ph_hi, li, pad;
};
struct Frame {
    LAS unsigned char* lds; LAS unsigned char* misc;
    int G, bid;
    const float *xp, *xs, *st_pool, *st_conv, *st_ret, *norm1_g, *w_in, *pool_w, *pool_scale, *conv_w, *ret_norm_g, *sgu_norm_g, *sgu_w, *sgu_b, *w_out, *norm2_g, *w_gu, *w_dn, *final_g;
    float* out;
    float *ROPE, *SSQ1, *SSQ2, *SSQS1, *SSQS2, *H, *KV, *SPART; unsigned* sgate; unsigned* fillq;
    bf16_t *POOLW, *SGUW, *WIN, *WOUT, *WGU, *WDN, *HB, *PB, *MIX, *ACT, *SB;
};

DI unsigned off_b(unsigned row, unsigned ch) { return 256u * row + 16u * (ch ^ (((row & 3u) << 2) | ((row >> 2) & 3u))); }
DI bf16x8 lds_rowfrag(const LAS unsigned char* tile, int lane, int rb, int s) { return *(const LAS bf16x8*)(tile + off_b((unsigned)((lane & 15) + 16 * rb), (unsigned)(4 * s + (lane >> 4)))); }
DI bf16x8 lds_trfrag(const LAS unsigned char* tile, int lane, int c, int ks) {
    const unsigned g = lane >> 4, q = (lane & 15) >> 2, p = lane & 3;
    const unsigned a0 = off_b(32u * ks + 8u * g + q, 2u * c + (p >> 1)) + 8u * (p & 1);
    const unsigned a1 = off_b(32u * ks + 8u * g + 4u + q, 2u * c + (p >> 1)) + 8u * (p & 1);
    const s16x4 lo = __builtin_amdgcn_ds_read_tr16_b64_v4i16((LAS s16x4*)(tile + a0));
    const s16x4 hi = __builtin_amdgcn_ds_read_tr16_b64_v4i16((LAS s16x4*)(tile + a1));
    return __builtin_shufflevector(lo, hi, 0, 1, 2, 3, 4, 5, 6, 7);
}
#define MFMA16(a, b, c) __builtin_amdgcn_mfma_f32_16x16x32_bf16((a), (b), (c), 0, 0, 0)

constexpr float LG2_GAMMA[4] = {-0.04580368961312479f, -0.02272007650008353f, -0.011315313227834146f, -0.005646563141142063f};
DI float lg2_gamma(int h) { return h == 0 ? LG2_GAMMA[0] : h == 1 ? LG2_GAMMA[1] : h == 2 ? LG2_GAMMA[2] : LG2_GAMMA[3]; }

constexpr int EPS_STRIDE = 132;
DI void epi_scatter(LAS float* scr, const f32x4 (&acc)[8], int lane) {
#pragma unroll
    for (int c = 0; c < 8; ++c)
#pragma unroll
        for (int r = 0; r < 4; ++r) scr[(4 * (lane >> 4) + r) * EPS_STRIDE + 16 * c + (lane & 15)] = acc[c][r];
}
DI void epi_gather(const LAS float* scr, int lane, int p, float (&v)[8]) {
    const LAS float* s = scr + (4 * p + (lane >> 4)) * EPS_STRIDE + 8 * (lane & 15);
    const f32x4 a = *(const LAS f32x4*)s, b = *(const LAS f32x4*)(s + 4);
    v[0] = a[0]; v[1] = a[1]; v[2] = a[2]; v[3] = a[3]; v[4] = b[0]; v[5] = b[1]; v[6] = b[2]; v[7] = b[3];
}
DI void unpack8(const u32x4 w, float (&x)[8]) { x[0] = bflo(w.x); x[1] = bfhi(w.x); x[2] = bflo(w.y); x[3] = bfhi(w.y); x[4] = bflo(w.z); x[5] = bfhi(w.z); x[6] = bflo(w.w); x[7] = bfhi(w.w); }
DI u32x4 pack8(const float (&x)[8]) { u32x4 w; w.x = pk2(x[0], x[1]); w.y = pk2(x[2], x[3]); w.z = pk2(x[4], x[5]); w.w = pk2(x[6], x[7]); return w; }

constexpr int WI_IN = (D / 64) * (INW / 64), WI_OUT = (D / 64) * (D / 64), WI_GU = (D / 64) * (GU / 64), WI_DN = (FF / 64) * (D / 64);
constexpr int WO_OUT = WI_IN, WO_GU = WO_OUT + WI_OUT, WO_DN = WO_GU + WI_GU, WI_L = WO_DN + WI_DN;
#ifndef HF_IN
#define HF_IN 3700
#endif
#ifndef HF_GU
#define HF_GU 2900
#endif
struct WItem { const float* wp; const float* gk; bf16_t* dst; int N, K; };
DI WItem witem_desc(Frame& F, int l, int r, int lane) {
    const float* W; const float* gk; bf16_t* WT; int N, K, item; bool gumap = false;
    if (r < WO_OUT) { W = F.w_in + (size_t)l * D * INW; WT = F.WIN + (size_t)l * INW * KPD; gk = F.norm1_g + l * D; N = INW; K = KPD; item = r; }
    else if (r < WO_GU) { W = F.w_out + (size_t)l * D * D; WT = F.WOUT + (size_t)l * D * KPD; gk = nullptr; N = D; K = KPD; item = r - WO_OUT; }
    else if (r < WO_DN) { W = F.w_gu + (size_t)l * D * GU; WT = F.WGU + (size_t)l * GU * KPD; gk = F.norm2_g + l * D; N = GU; K = KPD; item = r - WO_GU; gumap = true; }
    else { W = F.w_dn + (size_t)l * FF * D; WT = F.WDN + (size_t)l * D * KPF; gk = nullptr; N = D; K = KPF; item = r - WO_DN; }
    const int nblk = N / 64, kb = item / nblk, nb = item - kb * nblk, k0 = 64 * kb, n0 = 64 * nb;
    int d0 = n0; if (gumap) d0 = (n0 < FF) ? ((n0 >> 7) * 256 + (n0 & 127)) : (((n0 - FF) >> 7) * 256 + 128 + ((n0 - FF) & 127));
    WItem w; w.wp = W + (size_t)(k0 + (lane >> 4)) * N + n0 + 4 * (lane & 15); w.gk = gk ? gk + k0 : nullptr; w.dst = WT + (size_t)d0 * K + k0; w.N = N; w.K = K; return w;
}
DI void witem_load(const WItem& w, f32x4 (&v)[16]) {
#pragma unroll
    for (int i = 0; i < 16; ++i) v[i] = *(const f32x4*)(w.wp + (size_t)(4 * i) * w.N);
}
DI void witem_finish(const WItem& w, const f32x4 (&v)[16], LAS float* scr, int lane) {
#pragma unroll
    for (int i = 0; i < 16; ++i) { const int k = 4 * i + (lane >> 4); const float g = w.gk ? w.gk[k] : 1.0f; LAS float* d = scr + k * 65 + 4 * (lane & 15);
        d[0] = v[i][0] * g; d[1] = v[i][1] * g; d[2] = v[i][2] * g; d[3] = v[i][3] * g; }
    asm volatile("s_waitcnt lgkmcnt(0)" ::: "memory");
    const int c = lane & 7;
#pragma unroll
    for (int j = 0; j < 8; ++j) { const int n = (lane >> 3) + 8 * j; const LAS float* s = scr + (8 * c) * 65 + n;
        u32x4 o; o.x = pk2(s[0 * 65], s[1 * 65]); o.y = pk2(s[2 * 65], s[3 * 65]); o.z = pk2(s[4 * 65], s[5 * 65]); o.w = pk2(s[6 * 65], s[7 * 65]);
        *(u32x4*)(w.dst + (size_t)n * w.K + 8 * c) = o; }
    asm volatile("s_waitcnt lgkmcnt(0)" ::: "memory");
}
DI void weight_stream(Frame& F, int l, int first, int hi, int stride, LAS float* scr, int lane) {
    int it = first; if (it >= hi) return;
    f32x4 va[16], vb[16];
    WItem wa = witem_desc(F, l, it, lane), wb = wa; witem_load(wa, va);
    for (;;) {
        const int n1 = it + stride; const bool h1 = n1 < hi;
        if (h1) { wb = witem_desc(F, l, n1, lane); witem_load(wb, vb); }
        witem_finish(wa, va, scr, lane);
        if (!h1) break;
        const int n2 = n1 + stride; const bool h2 = n2 < hi;
        if (h2) { wa = witem_desc(F, l, n2, lane); witem_load(wa, va); }
        witem_finish(wb, vb, scr, lane);
        if (!h2) break;
        it = n2;
    }
}
DI void hole_fill(Frame& F, int first_idle, int n_idle, int l, int lo, int hi) {
    const int tid = opaque_tid(), lane = tid & 63, wave = __builtin_amdgcn_readfirstlane(tid >> 6);
    LAS float* scr = (LAS float*)(F.lds + wave * 16640);
    const bool split = first_idle > 0 && first_idle < F.G;
    if (n_idle < 0) n_idle = 0;
    const int mid = !split ? lo : (lo + n_idle < hi) ? lo + n_idle : hi;
    if (split && F.bid >= first_idle) weight_stream(F, l, lo + (F.bid - first_idle) * 8 + wave, mid, (F.G - first_idle) * 8, scr, lane);
    weight_stream(F, l, mid + F.bid * 8 + wave, hi, F.G * 8, scr, lane);
}
DI void p0_prologue(Frame& F) {
    const int tid = opaque_tid(), lane = tid & 63, wave = __builtin_amdgcn_readfirstlane(tid >> 6);
    LAS float* scr = (LAS float*)(F.lds + wave * 16640);
    const int gw = F.bid * 8 + wave, NGW = F.G * 8;
    weight_stream(F, 0, gw, WI_IN, NGW, scr, lane);
    if (FILL_MODE == 0) { weight_stream(F, 0, WI_IN + gw, WI_L, NGW, scr, lane); weight_stream(F, 1, gw, WI_L, NGW, scr, lane); }
    const int n2 = (WI_IN > NGW) ? WI_IN - NGW : 0, n1 = NGW - n2;
    const int rows_a = (n1 * 5 <= MV) ? n1 * 5 : 0;
    for (int k = 0; k < 5 + (MV - rows_a + NGW - 1) / NGW; ++k) {
        int m;
        if (k < 5) { if (rows_a == 0 || gw < n2) continue; m = (gw - n2) + k * n1; if (m >= rows_a) continue; }
        else { m = rows_a + gw + (k - 5) * NGW; if (m >= MV) continue; }
        const float* xrow = (m < MPR) ? F.xp + (size_t)m * D : F.xs + (size_t)(m - MPR) * D;
        const f32x4* xr = (const f32x4*)xrow + lane; float ss = 0.f; u32x2* o8 = (u32x2*)(F.HB + (size_t)m * D) + lane;
#pragma unroll
        for (int j = 0; j < 8; ++j) { const f32x4 v = xr[64 * j]; ss += (v[0] * v[0] + v[1] * v[1]) + (v[2] * v[2] + v[3] * v[3]); u32x2 w; w.x = pk2(v[0], v[1]); w.y = pk2(v[2], v[3]); o8[64 * j] = w; }
        ss = wave_sum(ss);
        if (m < MPR) { if (lane < 8) F.SSQ1[(size_t)m * 8 + lane] = (lane == 0) ? ss : 0.f; }
        else { F.SSQS1[(size_t)(m - MPR) * 128 + lane] = (lane == 0) ? ss : 0.f; F.SSQS1[(size_t)(m - MPR) * 128 + 64 + lane] = 0.f; }
    }
    const int gt = F.bid * 512 + tid, NGT = F.G * 512;
    for (int i = gt; i < 2049 * 64; i += NGT) { const int pi = i >> 6, f = i & 63; const float pos = (pi < 2048) ? (float)pi : 16384.0f;
        double pw = 1.0, bs = 0.8659643233600653523531691834202299819398;
#pragma unroll
        for (int bit = 0; bit < 6; ++bit) { if ((f >> bit) & 1) pw *= bs; bs *= bs; }
        const float inv = (float)pw; const float ang = pos * inv;
        const double a = (double)ang, kq = __builtin_rint(a * 0.63661977236758134308);
        double r = __builtin_fma(-kq, 1.57079632679489655800e+00, a); r = __builtin_fma(-kq, 6.12323399573676603587e-17, r);
        const double r2 = r * r;
        const double sp = r * (1.0 + r2 * (-1.0 / 6.0 + r2 * (1.0 / 120.0 + r2 * (-1.0 / 5040.0 + r2 * (1.0 / 362880.0 + r2 * (-1.0 / 39916800.0 + r2 * (1.0 / 6227020800.0 + r2 * (-1.0 / 1307674368000.0))))))));
        const double cp = 1.0 + r2 * (-0.5 + r2 * (1.0 / 24.0 + r2 * (-1.0 / 720.0 + r2 * (1.0 / 40320.0 + r2 * (-1.0 / 3628800.0 + r2 * (1.0 / 479001600.0 + r2 * (-1.0 / 87178291200.0 + r2 * (1.0 / 20922789888000.0))))))));
        const int q = (int)((long long)kq & 3);
        const double sn = (q == 0) ? sp : (q == 1) ? cp : (q == 2) ? -sp : -cp, cs = (q == 0) ? cp : (q == 1) ? -sp : (q == 2) ? -cp : sp;
        F.ROPE[2 * i] = (float)cs; F.ROPE[2 * i + 1] = (float)sn; }
    for (int i = gt; i < DEPTH * 4 * 128 * 128; i += NGT) { const int e = i & 127, g4 = (i >> 14) & 3, l = i >> 16;
        F.POOLW[i] = (bf16_t)(pk2(F.pool_w[i] * F.pool_scale[l * 512 + g4 * 128 + e], 0.f) & 0xffffu);
        const int s = i & 127, t = (i >> 7) & 127; F.SGUW[i] = (bf16_t)(pk2(t >= s ? F.sgu_w[i] : 0.f, 0.f) & 0xffffu); }
}

template <class RowMul>
DI void stage_rot(LAS unsigned char* tile, const bf16_t* src, const float* rope_pos0, int tid, RowMul rowmul) {
#pragma unroll
    for (int it = 0; it < 2; ++it) { const int task = tid + 512 * it, row = task >> 3, cp = task & 7;
        const u32x4 lo = *(const u32x4*)(src + (size_t)row * INW + 8 * cp), hi = *(const u32x4*)(src + (size_t)row * INW + 64 + 8 * cp);
        const f32x4* rp = (const f32x4*)(rope_pos0 + (size_t)row * 128 + 16 * cp);
        const f32x4 r0 = rp[0], r1 = rp[1], r2 = rp[2], r3 = rp[3];
        const float cs[8] = {r0[0], r0[2], r1[0], r1[2], r2[0], r2[2], r3[0], r3[2]}, sn[8] = {r0[1], r0[3], r1[1], r1[3], r2[1], r2[3], r3[1], r3[3]};
        float x1[8], x2[8], o1[8], o2[8]; unpack8(lo, x1); unpack8(hi, x2); const float sc = rowmul(row);
#pragma unroll
        for (int i = 0; i < 8; ++i) { o1[i] = (x1[i] * cs[i] - x2[i] * sn[i]) * sc; o2[i] = (x2[i] * cs[i] + x1[i] * sn[i]) * sc; }
        *(LAS u32x4*)(tile + off_b(row, cp)) = pack8(o1); *(LAS u32x4*)(tile + off_b(row, cp + 8)) = pack8(o2); }
}
DI void stage_copy(LAS unsigned char* tile, const bf16_t* src, int pitch, int tid) {
#pragma unroll
    for (int it = 0; it < 4; ++it) { const int task = tid + 512 * it, row = task >> 4, ch = task & 15;
        *(LAS u32x4*)(tile + off_b(row, ch)) = *(const u32x4*)(src + (size_t)row * pitch + 8 * ch); }
}

DI void ret_kv_unit(Frame& F, int b, int h, int n) {
    LAS unsigned char* TK = F.lds; LAS unsigned char* TV = F.lds + 32768;
    const int tid = opaque_tid(), lane = tid & 63, w = __builtin_amdgcn_readfirstlane(tid >> 6); const float lg = lg2_gamma(h);
    __syncthreads();
    const size_t row0 = (size_t)b * SEQ + (size_t)n * 128;
    { u32x4 vv[4];
      const bf16_t* vs = F.PB + row0 * INW + C_V + h * 128;
#pragma unroll
      for (int it = 0; it < 4; ++it) { const int task = tid + 512 * it; vv[it] = *(const u32x4*)(vs + (size_t)(task >> 4) * INW + 8 * (task & 15)); }
      stage_rot(TK, F.PB + row0 * INW + C_K + h * 128, F.ROPE + (size_t)(n * 128) * 128, tid, [lg](int row) { return 0.08838834764831845f * exp2f((float)(127 - row) * lg); });
#pragma unroll
      for (int it = 0; it < 4; ++it) { const int task = tid + 512 * it; *(LAS u32x4*)(TV + off_b(task >> 4, task & 15)) = vv[it]; } }
    __syncthreads();
    f32x4 acc[8];
#pragma unroll
    for (int c = 0; c < 8; ++c) acc[c] = (f32x4){0.f, 0.f, 0.f, 0.f};
#pragma unroll
    for (int ks = 0; ks < 4; ++ks) { const bf16x8 a = lds_trfrag(TK, lane, w, ks);
#pragma unroll
        for (int c = 0; c < 8; ++c) { const bf16x8 bb = lds_trfrag(TV, lane, c, ks); acc[c] = MFMA16(a, bb, acc[c]); } }
    float* kv = F.KV + ((size_t)((b * 4 + h) * NCH + n)) * 16384;
#pragma unroll
    for (int c = 0; c < 8; ++c)
#pragma unroll
        for (int r = 0; r < 4; ++r) kv[(16 * w + 4 * (lane >> 4) + r) * 128 + 16 * c + (lane & 15)] = acc[c][r];
}

DI void ret_out_unit(Frame& F, int l, int b, int h, int n) {
    LAS unsigned char* TQ = F.lds; LAS unsigned char* TK = F.lds + 32768; LAS unsigned char* TV = F.lds + 65536; LAS unsigned char* TS = F.lds + 98304;
    const int tid = opaque_tid(), lane = tid & 63, w = __builtin_amdgcn_readfirstlane(tid >> 6); const float lg = lg2_gamma(h);
    __syncthreads();
    const size_t row0 = (size_t)b * SEQ + (size_t)n * 128;
    const float* rope0 = F.ROPE + (size_t)(n * 128) * 128;
    {
        const bf16_t* qs = F.PB + row0 * INW + C_Q + h * 128; const bf16_t* ks_ = F.PB + row0 * INW + C_K + h * 128; const bf16_t* vs = F.PB + row0 * INW + C_V + h * 128;
        const bf16_t* ss = F.SB + ((size_t)((b * 4 + h) * NCH + n)) * 16384;
        u32x4 qlo[2], qhi[2], klo[2], khi[2], vv[4], sv[4]; f32x4 rr[2][4];
#pragma unroll
        for (int it = 0; it < 2; ++it) { const int task = tid + 512 * it, row = task >> 3, cp = task & 7;
            qlo[it] = *(const u32x4*)(qs + (size_t)row * INW + 8 * cp); qhi[it] = *(const u32x4*)(qs + (size_t)row * INW + 64 + 8 * cp);
            klo[it] = *(const u32x4*)(ks_ + (size_t)row * INW + 8 * cp); khi[it] = *(const u32x4*)(ks_ + (size_t)row * INW + 64 + 8 * cp);
            const f32x4* rp = (const f32x4*)(rope0 + (size_t)row * 128 + 16 * cp); rr[it][0] = rp[0]; rr[it][1] = rp[1]; rr[it][2] = rp[2]; rr[it][3] = rp[3]; }
#pragma unroll
        for (int it = 0; it < 4; ++it) { const int task = tid + 512 * it, row = task >> 4, ch = task & 15;
            vv[it] = *(const u32x4*)(vs + (size_t)row * INW + 8 * ch); sv[it] = (u32x4){0u, 0u, 0u, 0u}; if (n > 0) sv[it] = *(const u32x4*)(ss + (size_t)row * 128 + 8 * ch); }
#pragma unroll
        for (int it = 0; it < 2; ++it) { const int task = tid + 512 * it, row = task >> 3, cp = task & 7;
            const f32x4 r0 = rr[it][0], r1 = rr[it][1], r2 = rr[it][2], r3 = rr[it][3];
            const float cs[8] = {r0[0], r0[2], r1[0], r1[2], r2[0], r2[2], r3[0], r3[2]}, sn[8] = {r0[1], r0[3], r1[1], r1[3], r2[1], r2[3], r3[1], r3[3]};
            float x1[8], x2[8], o1[8], o2[8];
            unpack8(qlo[it], x1); unpack8(qhi[it], x2);
#pragma unroll
            for (int i = 0; i < 8; ++i) { o1[i] = x1[i] * cs[i] - x2[i] * sn[i]; o2[i] = x2[i] * cs[i] + x1[i] * sn[i]; }
            *(LAS u32x4*)(TQ + off_b(row, cp)) = pack8(o1); *(LAS u32x4*)(TQ + off_b(row, cp + 8)) = pack8(o2);
            unpack8(klo[it], x1); unpack8(khi[it], x2);
#pragma unroll
            for (int i = 0; i < 8; ++i) { o1[i] = (x1[i] * cs[i] - x2[i] * sn[i]) * 0.08838834764831845f; o2[i] = (x2[i] * cs[i] + x1[i] * sn[i]) * 0.08838834764831845f; }
            *(LAS u32x4*)(TK + off_b(row, cp)) = pack8(o1); *(LAS u32x4*)(TK + off_b(row, cp + 8)) = pack8(o2); }
#pragma unroll
        for (int it = 0; it < 4; ++it) { const int task = tid + 512 * it, row = task >> 4, ch = task & 15;
            *(LAS u32x4*)(TV + off_b(row, ch)) = vv[it]; if (n > 0) *(LAS u32x4*)(TS + off_b(row, ch)) = sv[it]; }
    }
    __syncthreads();
    f32x4 acc[8];
#pragma unroll
    for (int c = 0; c < 8; ++c) acc[c] = (f32x4){0.f, 0.f, 0.f, 0.f};
    bf16x8 qf[4];
#pragma unroll
    for (int s = 0; s < 4; ++s) qf[s] = lds_rowfrag(TQ, lane, w, s);
    if (n > 0) {
#pragma unroll
        for (int s = 0; s < 4; ++s)
#pragma unroll
            for (int c = 0; c < 8; ++c) { const bf16x8 bb = lds_trfrag(TS, lane, c, s); acc[c] = MFMA16(qf[s], bb, acc[c]); }
        float f[4];
#pragma unroll
        for (int r = 0; r < 4; ++r) f[r] = exp2f((float)(16 * w + 4 * (lane >> 4) + r + 1) * lg);
#pragma unroll
        for (int c = 0; c < 8; ++c)
#pragma unroll
            for (int r = 0; r < 4; ++r) acc[c][r] *= f[r];
    }
    const int i_loc = 16 * w + (lane & 15);
#pragma unroll
    for (int c = 0; c < 8; ++c) if (c <= w) {
        f32x4 sc = (f32x4){0.f, 0.f, 0.f, 0.f};
#pragma unroll
        for (int s = 0; s < 4; ++s) { const bf16x8 kf = lds_rowfrag(TK, lane, c, s); sc = MFMA16(kf, qf[s], sc); }
        float pv[4];
#pragma unroll
        for (int r = 0; r < 4; ++r) { const int j = 16 * c + 4 * (lane >> 4) + r; const int dd = i_loc - j; pv[r] = dd >= 0 ? sc[r] * exp2f((float)dd * lg) : 0.f; }
        u32x2 o; o.x = pk2(pv[0], pv[1]); o.y = pk2(pv[2], pv[3]);
        *(LAS u32x2*)(TQ + off_b(i_loc, 2 * c + (lane >> 5)) + 8 * ((lane >> 4) & 1)) = o;
    }
    if ((w & 1) == 0) { unsigned zz = 0u; asm volatile("" : "+v"(zz)); u32x2 z; z.x = zz; z.y = zz; *(LAS u32x2*)(TQ + off_b(i_loc, 2 * (w + 1) + (lane >> 5)) + 8 * ((lane >> 4) & 1)) = z; }
#pragma unroll
    for (int ks = 0; ks < 4; ++ks) if (ks <= (w >> 1)) { const bf16x8 a = lds_rowfrag(TQ, lane, w, ks);
#pragma unroll
        for (int c = 0; c < 8; ++c) { const bf16x8 bb = lds_trfrag(TV, lane, c, ks); acc[c] = MFMA16(a, bb, acc[c]); } }
#pragma unroll
    for (int r = 0; r < 4; ++r) { float s = 0.f;
#pragma unroll
        for (int c = 0; c < 8; ++c) s += acc[c][r];
        s += __shfl_xor(s, 1); s += __shfl_xor(s, 2); s += __shfl_xor(s, 4); s += __shfl_xor(s, 8);
        const float mean = s * (1.0f / 128.0f); float q = 0.f;
#pragma unroll
        for (int c = 0; c < 8; ++c) { const float d = acc[c][r] - mean; acc[c][r] = d; q += d * d; }
        q += __shfl_xor(q, 1); q += __shfl_xor(q, 2); q += __shfl_xor(q, 4); q += __shfl_xor(q, 8);
        const float rstd = __builtin_amdgcn_rsqf(q * (1.0f / 128.0f) + NORM_EPS);
#pragma unroll
        for (int c = 0; c < 8; ++c) acc[c][r] *= rstd; }
    __syncthreads();
    LAS float* scr = (LAS float*)(F.lds + w * 8448);
    epi_scatter(scr, acc, lane);
    const float* gn = F.ret_norm_g + l * 512 + h * 128 + 8 * (lane & 15);
    const f32x4 g0 = *(const f32x4*)gn, g1 = *(const f32x4*)(gn + 4);
    const float gg[8] = {g0[0], g0[1], g0[2], g0[3], g1[0], g1[1], g1[2], g1[3]};
#pragma unroll
    for (int p = 0; p < 4; ++p) { float v[8]; epi_gather(scr, lane, p, v); const size_t grow = row0 + 16 * w + 4 * p + (lane >> 4);
        float gt[8]; unpack8(*(const u32x4*)(F.PB + grow * INW + C_G + h * 128 + 8 * (lane & 15)), gt);
#pragma unroll
        for (int i = 0; i < 8; ++i) v[i] = v[i] * gg[i] * silu_f(gt[i]);
        *(u32x4*)(F.MIX + grow * D + 1024 + h * 128 + 8 * (lane & 15)) = pack8(v); }
}

DI void pool_unit(Frame& F, int l, int b, int tt, int gi) {
    LAS unsigned char* TA = F.lds; LAS unsigned char* TD = F.lds + 40960; LAS unsigned char* TW = F.lds + 73728;
    const int tid = opaque_tid(), lane = tid & 63, w = __builtin_amdgcn_readfirstlane(tid >> 6);
    __syncthreads();
    { u32x4 v[5];
#pragma unroll
      for (int it = 0; it < 5; ++it) { const int task = tid + 512 * it, r = task >> 4, ch = task & 15, tseq = tt * 128 - 15 + r;
          v[it] = (u32x4){0u, 0u, 0u, 0u};
          if (task < 143 * 16 && tseq >= 0) v[it] = *(const u32x4*)(F.PB + ((size_t)b * SEQ + tseq) * INW + C_A + gi * 128 + 8 * ch); }
#pragma unroll
      for (int it = 0; it < 5; ++it) { const int task = tid + 512 * it; if (task < 143 * 16) *(LAS u32x4*)(TA + (task >> 4) * 256 + (task & 15) * 16) = v[it]; } }
    stage_copy(TW, F.POOLW + (size_t)((l * 4 + gi) * 128) * 128, 128, tid);
    __syncthreads();
    const int win = 2 << gi;
    { float s[4][8], a[4][8];
#pragma unroll
      for (int it = 0; it < 4; ++it) { const int task = tid + 512 * it, t = task >> 4, ch = task & 15; unpack8(*(const LAS u32x4*)(TA + (t + 15) * 256 + ch * 16), a[it]);
#pragma unroll
          for (int i = 0; i < 8; ++i) s[it][i] = a[it][i]; }
      for (int j = 1; j < win; ++j) {
#pragma unroll
          for (int it = 0; it < 4; ++it) { const int task = tid + 512 * it, t = task >> 4, ch = task & 15; float x[8]; unpack8(*(const LAS u32x4*)(TA + (t + 15 - j) * 256 + ch * 16), x);
#pragma unroll
              for (int i = 0; i < 8; ++i) s[it][i] += x[i]; } }
#pragma unroll
      for (int it = 0; it < 4; ++it) { const int task = tid + 512 * it, t = task >> 4, ch = task & 15;
          const int pos = tt * 128 + t; const float inv = 1.0f / (float)(pos + 1 < win ? pos + 1 : win);
          float d[8];
#pragma unroll
          for (int i = 0; i < 8; ++i) d[i] = s[it][i] * inv - a[it][i];
          *(LAS u32x4*)(TD + off_b(t, ch)) = pack8(d);
          if (tt == NCH - 1 && t >= 113) { float* o = F.out + O_POOLP + ((size_t)((l * NB + b) * 15 + (t - 113))) * 512 + gi * 128 + 8 * ch;
              *(f32x4*)o = (f32x4){a[it][0], a[it][1], a[it][2], a[it][3]}; *(f32x4*)(o + 4) = (f32x4){a[it][4], a[it][5], a[it][6], a[it][7]}; } } }
    __syncthreads();
    f32x4 acc[8];
#pragma unroll
    for (int c = 0; c < 8; ++c) acc[c] = (f32x4){0.f, 0.f, 0.f, 0.f};
#pragma unroll
    for (int s = 0; s < 4; ++s) { const bf16x8 a = lds_rowfrag(TD, lane, w, s);
#pragma unroll
        for (int c = 0; c < 8; ++c) { const bf16x8 bb = lds_trfrag(TW, lane, c, s); acc[c] = MFMA16(a, bb, acc[c]); } }
    __syncthreads();
    LAS float* scr = (LAS float*)(F.lds + w * 8448);
    epi_scatter(scr, acc, lane);
#pragma unroll
    for (int p = 0; p < 4; ++p) { float v[8]; epi_gather(scr, lane, p, v); const size_t grow = (size_t)b * SEQ + tt * 128 + 16 * w + 4 * p + (lane >> 4);
        *(u32x4*)(F.MIX + grow * D + gi * 128 + 8 * (lane & 15)) = pack8(v); }
}

DI void sgu_unit(Frame& F, int l, int b, int ck, int h) {
    LAS unsigned char* TV = F.lds;
    const int tid = opaque_tid(), lane = tid & 63, w = __builtin_amdgcn_readfirstlane(tid >> 6);
    __syncthreads();
    const size_t row0 = (size_t)b * SEQ + (size_t)ck * 128;
    { const float* gp = F.sgu_norm_g + l * 512 + 8 * lane; const f32x4 g0 = *(const f32x4*)gp, g1 = *(const f32x4*)(gp + 4);
      const float gg[8] = {g0[0], g0[1], g0[2], g0[3], g1[0], g1[1], g1[2], g1[3]};
      u32x4 raw[16];
#pragma unroll
      for (int it = 0; it < 16; ++it) raw[it] = *(const u32x4*)(F.PB + (row0 + 16 * w + it) * INW + C_VV + 8 * lane);
      float sm[16], sq[16];
#pragma unroll
      for (int it = 0; it < 16; ++it) { float x[8]; unpack8(raw[it], x); sm[it] = ((x[0] + x[1]) + (x[2] + x[3])) + ((x[4] + x[5]) + (x[6] + x[7])); }
#pragma unroll
      for (int o = 1; o < 64; o <<= 1)
#pragma unroll
          for (int it = 0; it < 16; ++it) sm[it] += __shfl_xor(sm[it], o);
#pragma unroll
      for (int it = 0; it < 16; ++it) { float x[8]; unpack8(raw[it], x); const float mean = sm[it] * (1.0f / 512.0f); sm[it] = mean; float q = 0.f;
#pragma unroll
          for (int i = 0; i < 8; ++i) { const float d = x[i] - mean; q += d * d; }
          sq[it] = q; }
#pragma unroll
      for (int o = 1; o < 64; o <<= 1)
#pragma unroll
          for (int it = 0; it < 16; ++it) sq[it] += __shfl_xor(sq[it], o);
      if ((lane >> 4) == h) {
#pragma unroll
        for (int it = 0; it < 16; ++it) { const int st = 16 * w + it; float x[8]; unpack8(raw[it], x);
            const float mean = sm[it], rstd = __builtin_amdgcn_rsqf(sq[it] * (1.0f / 512.0f) + NORM_EPS);
#pragma unroll
            for (int i = 0; i < 8; ++i) x[i] = (x[i] - mean) * rstd * gg[i];
            *(LAS u32x4*)(TV + off_b(st, lane & 15)) = pack8(x);
            if (ck == NCH - 1) { float* o = F.out + O_SGUP + ((size_t)((l * NB + b) * 128 + st)) * 512 + 8 * lane;
                *(f32x4*)o = (f32x4){x[0], x[1], x[2], x[3]}; *(f32x4*)(o + 4) = (f32x4){x[4], x[5], x[6], x[7]}; } } } }
    __syncthreads();
    f32x4 acc[8];
#pragma unroll
    for (int c = 0; c < 8; ++c) acc[c] = (f32x4){0.f, 0.f, 0.f, 0.f};
    const bf16_t* wrow = F.SGUW + ((size_t)((l * 4 + h) * 128 + 16 * w + (lane & 15))) * 128 + 8 * (lane >> 4);
#pragma unroll
    for (int ks = 0; ks < 4; ++ks) if (ks <= (w >> 1)) { const bf16x8 a = *(const bf16x8*)(wrow + 32 * ks);
#pragma unroll
        for (int c = 0; c < 8; ++c) { const bf16x8 bb = lds_trfrag(TV, lane, c, ks); acc[c] = MFMA16(a, bb, acc[c]); } }
    __syncthreads();
    LAS float* scr = (LAS float*)(F.lds + w * 8448);
    epi_scatter(scr, acc, lane);
#pragma unroll
    for (int p = 0; p < 4; ++p) { float v[8]; epi_gather(scr, lane, p, v); const int t = 16 * w + 4 * p + (lane >> 4); const size_t grow = row0 + t;
        const float bias = F.sgu_b[(l * 4 + h) * 128 + t];
        float u[8]; unpack8(*(const u32x4*)(F.PB + grow * INW + C_U + h * 128 + 8 * (lane & 15)), u);
#pragma unroll
        for (int i = 0; i < 8; ++i) v[i] = u[i] * (v[i] + bias);
        *(u32x4*)(F.MIX + grow * D + 1536 + h * 128 + 8 * (lane & 15)) = pack8(v); }
}

DI void conv_flat(Frame& F, int l) {
    const float* cw = F.conv_w + l * 3 * 512; const int tid = opaque_tid();
    const int b0 = (F.G == 256) ? 128 : 0;
    if (F.bid < b0) return;
    for (int task = (F.bid - b0) * 512 + tid; task < MPR * 64; task += (F.G - b0) * 512) { const int row = task >> 6, ch = task & 63, t = row & (SEQ - 1), b = row >> 11;
        const bf16_t* p = F.PB + (size_t)row * INW + 8 * ch;
        float z[3][8];
#pragma unroll
        for (int k = 0; k < 3; ++k) { const int back = 2 - k;
            if (t - back >= 0) { float cg[8], hh[8]; unpack8(*(const u32x4*)(p - (size_t)back * INW + C_CG), cg); unpack8(*(const u32x4*)(p - (size_t)back * INW + C_HH), hh);
#pragma unroll
                for (int i = 0; i < 8; ++i) z[k][i] = cg[i] * hh[i]; }
            else {
#pragma unroll
                for (int i = 0; i < 8; ++i) z[k][i] = 0.f; } }
        float bg[8], y[8]; unpack8(*(const u32x4*)(p + C_BG), bg);
#pragma unroll
        for (int i = 0; i < 8; ++i) { const int c = 8 * ch + i; y[i] = bg[i] * (z[0][i] * cw[c] + z[1][i] * cw[512 + c] + z[2][i] * cw[1024 + c]); }
        *(u32x4*)(F.MIX + (size_t)row * D + 512 + 8 * ch) = pack8(y);
        if (t >= SEQ - 2) { float* o = F.out + O_CONVP + ((size_t)((l * NB + b) * 2 + (t - (SEQ - 2)))) * 512 + 8 * ch;
            *(f32x4*)o = (f32x4){z[2][0], z[2][1], z[2][2], z[2][3]}; *(f32x4*)(o + 4) = (f32x4){z[2][4], z[2][5], z[2][6], z[2][7]}; }
    }
}

DI void ret_scan_flat(Frame& F, int l) {
    const int tid = opaque_tid();
    for (int task = F.bid * 512 + tid; task < 16 * 4096; task += F.G * 512) { const int bh = task >> 12, e4 = task & 4095, h = bh & 3; const float g = exp2f(128.0f * lg2_gamma(h));
        const float* kvb = F.KV + (size_t)bh * NCH * 16384 + 4 * e4; bf16_t* sb = F.SB + (size_t)bh * NCH * 16384 + 4 * e4;
        f32x4 kv[NCH];
#pragma unroll
        for (int m = 0; m < NCH; ++m) kv[m] = *(const f32x4*)(kvb + (size_t)m * 16384);
        f32x4 st = kv[0];
#pragma unroll
        for (int n = 1; n < NCH; ++n) { u32x2 o; o.x = pk2(st[0], st[1]); o.y = pk2(st[2], st[3]); *(u32x2*)(sb + (size_t)n * 16384) = o; st = st * g + kv[n]; }
        *(f32x4*)(F.out + O_RETP + ((size_t)(l * 16 + bh)) * 16384 + 4 * e4) = st; }
}

DI void sret_unit(Frame& F, int l, int s, int h) {
    LAS float* qf = (LAS float*)F.lds; LAS float* kf = qf + 128; LAS float* vf = qf + 256; LAS float* red = qf + 384;
    const int tid = opaque_tid(), lane = tid & 63; const size_t row = (size_t)MPR + s; const float gam = exp2f(lg2_gamma(h));
    __syncthreads();
    if (tid < 64) { const bf16_t* p = F.PB + row * INW + h * 128; const float* rp = F.ROPE + ((size_t)ROPE_SPOS * 64 + tid) * 2; const float cs = rp[0], sn = rp[1];
        const float q1 = bf2f(p[C_Q + tid]), q2 = bf2f(p[C_Q + 64 + tid]), k1 = bf2f(p[C_K + tid]), k2 = bf2f(p[C_K + 64 + tid]);
        qf[tid] = q1 * cs - q2 * sn; qf[tid + 64] = q2 * cs + q1 * sn;
        kf[tid] = (k1 * cs - k2 * sn) * 0.08838834764831845f; kf[tid + 64] = (k2 * cs + k1 * sn) * 0.08838834764831845f;
        vf[tid] = bf2f(p[C_V + tid]); vf[tid + 64] = bf2f(p[C_V + 64 + tid]); }
    __syncthreads();
    const int dg = tid >> 5, e4 = (tid & 31) * 4;
    const size_t sb = ((size_t)((l * NS + s) * 4 + h)) * 16384;
    const float* s0 = F.st_ret + sb; float* so = F.out + O_RETS + sb;
    const f32x4 vv = *(const LAS f32x4*)(vf + e4); f32x4 o = (f32x4){0.f, 0.f, 0.f, 0.f};
#pragma unroll
    for (int it = 0; it < 8; ++it) { const int d = dg + 16 * it; const f32x4 a = *(const f32x4*)(s0 + d * 128 + e4); const f32x4 sn = a * gam + vv * kf[d];
        *(f32x4*)(so + d * 128 + e4) = sn; o += sn * qf[d]; }
    *(LAS f32x4*)(red + dg * 128 + e4) = o;
    __syncthreads();
    if (tid < 64) { float o0 = 0.f, o1 = 0.f;
#pragma unroll
        for (int g = 0; g < 16; ++g) { o0 += red[g * 128 + lane]; o1 += red[g * 128 + 64 + lane]; }
        const float mean = wave_sum(o0 + o1) * (1.0f / 128.0f); o0 -= mean; o1 -= mean;
        const float rstd = __builtin_amdgcn_rsqf(wave_sum(o0 * o0 + o1 * o1) * (1.0f / 128.0f) + NORM_EPS);
        const bf16_t* gp = F.PB + row * INW + C_G + h * 128; const float* gn = F.ret_norm_g + l * 512 + h * 128;
        bf16_t* mo = F.MIX + row * D + 1024 + h * 128;
        mo[lane] = (bf16_t)(pk2(o0 * rstd * gn[lane] * silu_f(bf2f(gp[lane])), 0.f) & 0xffffu);
        mo[lane + 64] = (bf16_t)(pk2(o1 * rstd * gn[lane + 64] * silu_f(bf2f(gp[lane + 64])), 0.f) & 0xffffu); }
}

DI void smisc_unit(Frame& F, int l, int s) {
    LAS float* dl = (LAS float*)F.lds; LAS float* red = dl + 512;
    const int tid = opaque_tid(), lane = tid & 63, w = __builtin_amdgcn_readfirstlane(tid >> 6); const size_t row = (size_t)MPR + s; const bf16_t* p = F.PB + row * INW;
    __syncthreads();
    {
        const int gi = tid >> 7, win = 2 << gi; const float a0 = bf2f(p[C_A + tid]);
        const float* prev = F.st_pool + ((size_t)(l * NS + s) * 15) * 512 + tid; float* po = F.out + O_POOLS + ((size_t)(l * NS + s) * 15) * 512 + tid;
        float ws = a0;
#pragma unroll
        for (int j = 0; j < 15; ++j) { const float pj = prev[(size_t)j * 512]; if (15 - j < win) ws += pj; if (j >= 1) po[(size_t)(j - 1) * 512] = pj; }
        po[(size_t)14 * 512] = a0;
        dl[tid] = ws / (float)win - a0;
    }
    {
        const float z0 = bf2f(p[C_CG + tid]) * bf2f(p[C_HH + tid]); const float* cw = F.conv_w + l * 3 * 512 + tid;
        const float* pc = F.st_conv + ((size_t)(l * NS + s) * 2) * 512 + tid; const float p0 = pc[0], p1 = pc[512];
        const float y = bf2f(p[C_BG + tid]) * (p0 * cw[0] + p1 * cw[512] + z0 * cw[1024]);
        F.MIX[row * D + 512 + tid] = (bf16_t)(pk2(y, 0.f) & 0xffffu);
        float* co = F.out + O_CONVS + ((size_t)(l * NS + s) * 2) * 512 + tid; co[0] = p1; co[512] = z0;
    }
    const float vvx = bf2f(p[C_VV + tid]);
    { const float sm = wave_sum(vvx); if (lane == 0) red[w] = sm; }
    __syncthreads();
    float mean = 0.f;
#pragma unroll
    for (int i = 0; i < 8; ++i) mean += red[i];
    mean *= (1.0f / 512.0f);
    const float dv = vvx - mean;
    { const float sq = wave_sum(dv * dv); if (lane == 0) red[8 + w] = sq; }
    {
        const int gi = tid >> 7, e = tid & 127; const bf16_t* wp = F.POOLW + ((size_t)(l * 4 + gi) * 128) * 128 + e; float y = 0.f;
#pragma unroll 8
        for (int c = 0; c < 128; ++c) y += dl[gi * 128 + c] * bf2f(wp[(size_t)c * 128]);
        F.MIX[row * D + tid] = (bf16_t)(pk2(y, 0.f) & 0xffffu);
    }
    __syncthreads();
    float var = 0.f;
#pragma unroll
    for (int i = 0; i < 8; ++i) var += red[8 + i];
    const float rstd = __builtin_amdgcn_rsqf(var * (1.0f / 512.0f) + NORM_EPS);
    const float vn = dv * rstd * F.sgu_norm_g[l * 512 + tid];
    F.out[O_SGUS + (size_t)(l * NS + s) * 512 + tid] = vn;
    const int h = tid >> 7; const float mixed = F.sgu_w[(size_t)(l * 4 + h) * 16384] * vn + F.sgu_b[(l * 4 + h) * 128];
    F.MIX[row * D + 1536 + tid] = (bf16_t)(pk2(bf2f(p[C_U + tid]) * mixed, 0.f) & 0xffffu);
}

template <int KS>
DI void skinny_splitk_piece(LAS unsigned char* lds, const bf16_t* A, int lda, const bf16_t* Bt, int ldb, int piece, float* SP) {
    const int tid = opaque_tid(), lane = tid & 63, w = __builtin_amdgcn_readfirstlane(tid >> 6);
    const int cb = piece & 31, sl = piece >> 5, k0 = sl * KS;
    constexpr int RS = KS * 2 + 16, CPR = KS / 8, NKS = KS / 32;
    __syncthreads();
    for (int c = tid; c < 64 * CPR; c += 512) { const int r = c / CPR, ch = c - r * CPR;
        *(LAS u32x4*)(lds + r * RS + ch * 16) = *(const u32x4*)(Bt + (size_t)(64 * cb + r) * ldb + k0 + 8 * ch); }
    const bf16_t* ap = A + (size_t)(16 * w + (lane & 15)) * lda + k0 + 8 * (lane >> 4);
    bf16x8 af[NKS];
#pragma unroll
    for (int ks = 0; ks < NKS; ++ks) af[ks] = *(const bf16x8*)(ap + 32 * ks);
    __syncthreads();
    f32x4 acc[4];
#pragma unroll
    for (int c = 0; c < 4; ++c) acc[c] = (f32x4){0.f, 0.f, 0.f, 0.f};
    const LAS unsigned char* bp = lds + (lane & 15) * RS + (lane >> 4) * 16;
#pragma unroll
    for (int ks = 0; ks < NKS; ++ks)
#pragma unroll
        for (int c = 0; c < 4; ++c) { const bf16x8 bb = *(const LAS bf16x8*)(bp + 16 * c * RS + 64 * ks); acc[c] = MFMA16(bb, af[ks], acc[c]); }
    float* o = SP + ((size_t)sl * NS + 16 * w + (lane & 15)) * D + 64 * cb + 4 * (lane >> 4);
#pragma unroll
    for (int c = 0; c < 4; ++c) *(f32x4*)(o + 16 * c) = acc[c];
}
template <bool BASE_BF16, bool OUT_F32>
DI void sample_finalize(const float* SP, int r, const float* base_f, const bf16_t* base_b, float* Hs, bf16_t* HBs, float* ssqs) {
    const int tid = opaque_tid(), lane = tid & 63, w = __builtin_amdgcn_readfirstlane(tid >> 6);
    const size_t off = (size_t)r * D + 256 * w + 4 * lane;
    f32x4 p[8];
#pragma unroll
    for (int sl = 0; sl < 8; ++sl) p[sl] = *(const f32x4*)(SP + (size_t)sl * NS * D + off);
    f32x4 h;
    if (BASE_BF16) { const u32x2 x = *(const u32x2*)(base_b + off); h = (f32x4){bflo(x.x), bfhi(x.x), bflo(x.y), bfhi(x.y)}; } else h = *(const f32x4*)(base_f + off);
#pragma unroll
    for (int sl = 0; sl < 8; ++sl) h += p[sl];
    if (OUT_F32) *(f32x4*)(Hs + off) = h; else { u32x2 o; o.x = pk2(h[0], h[1]); o.y = pk2(h[2], h[3]); *(u32x2*)(HBs + off) = o; }
    const float ss = wave_sum((h[0] * h[0] + h[1] * h[1]) + (h[2] * h[2] + h[3] * h[3]));
    if (lane < 16) ssqs[(size_t)r * 128 + 16 * w + lane] = (lane == 0) ? ss : 0.f;
}

DI void sample_final_row(Frame& F, int r) {
    const int tid = opaque_tid(), lane = tid & 63, w = __builtin_amdgcn_readfirstlane(tid >> 6);
    LAS float* red = (LAS float*)F.misc;
    const size_t off = (size_t)r * D + 256 * w + 4 * lane;
    f32x4 p[8];
#pragma unroll
    for (int sl = 0; sl < 8; ++sl) p[sl] = *(const f32x4*)(F.SPART + (size_t)sl * NS * D + off);
    const u32x2 x = *(const u32x2*)(F.HB + (size_t)MPR * D + off); f32x4 h = (f32x4){bflo(x.x), bfhi(x.x), bflo(x.y), bfhi(x.y)};
#pragma unroll
    for (int sl = 0; sl < 8; ++sl) h += p[sl];
    const float ss = wave_sum((h[0] * h[0] + h[1] * h[1]) + (h[2] * h[2] + h[3] * h[3]));
    __syncthreads();
    if (lane == 0) red[w] = ss;
    __syncthreads();
    float tot = 0.f;
#pragma unroll
    for (int i = 0; i < 8; ++i) tot += red[i];
    const float rs = __builtin_amdgcn_rsqf(tot * (1.0f / (float)D) + NORM_EPS);
    const f32x4 g = *(const f32x4*)(F.final_g + 256 * w + 4 * lane);
    *(f32x4*)(F.out + O_YS + off) = h * rs * g;
}

DI void final_norm(Frame& F) {
    const int tid = opaque_tid(), lane = tid & 63, wave = __builtin_amdgcn_readfirstlane(tid >> 6);
    const int gw = F.bid * 8 + wave, NGW = F.G * 8;
    for (int r = F.bid; r < NS; r += F.G) sample_final_row(F, r);
    for (int m = gw; m < MPR; m += NGW) { const float rs = pg8::row_rstd(F.SSQ1, F.SSQS1, m);
        const u32x2* hr = (const u32x2*)(F.HB + (size_t)m * D) + lane; const f32x4* gr = (const f32x4*)F.final_g + lane;
        f32x4* o = (f32x4*)(F.out + O_YP + (size_t)m * D) + lane;
        u32x2 hv[8];
#pragma unroll
        for (int j = 0; j < 8; ++j) hv[j] = hr[64 * j];
#pragma unroll
        for (int j = 0; j < 8; ++j) { const f32x4 h = (f32x4){bflo(hv[j].x), bfhi(hv[j].x), bflo(hv[j].y), bfhi(hv[j].y)}; o[64 * j] = h * rs * gr[64 * j]; } }
}

constexpr int N_PHASES = 2 + 7 * DEPTH;
#define MKFRAME() Frame F; { const __attribute__((address_space(4))) Args* ap = (const __attribute__((address_space(4))) Args*)__builtin_amdgcn_kernarg_segment_ptr(); asm volatile("" : "+s"(ap)); const __attribute__((address_space(4))) Args& A_ = *ap; unsigned char* ws = A_.ws; \
    F.lds = lds_; F.misc = F.lds + MISC_OFF; F.G = gridDim.x; F.bid = blockIdx.x; \
    F.xp = A_.in[0]; F.xs = A_.in[1]; F.st_pool = A_.in[2]; F.st_conv = A_.in[3]; F.st_ret = A_.in[4]; F.norm1_g = A_.in[5]; F.w_in = A_.in[6]; \
    F.pool_w = A_.in[7]; F.pool_scale = A_.in[8]; F.conv_w = A_.in[9]; F.ret_norm_g = A_.in[10]; F.sgu_norm_g = A_.in[11]; F.sgu_w = A_.in[12]; F.sgu_b = A_.in[13]; \
    F.w_out = A_.in[14]; F.norm2_g = A_.in[15]; F.w_gu = A_.in[16]; F.w_dn = A_.in[17]; F.final_g = A_.in[18]; F.out = A_.out; \
    F.ROPE = (float*)(ws + WS_ROPE); F.SSQ1 = (float*)(ws + WS_SSQ1); F.SSQ2 = (float*)(ws + WS_SSQ2); F.SSQS1 = (float*)(ws + WS_SSQS1); F.SSQS2 = (float*)(ws + WS_SSQS2); F.H = (float*)(ws + WS_H); F.KV = (float*)(ws + WS_KV); F.SPART = (float*)(ws + WS_SPART); F.sgate = (unsigned*)(ws + WS_CTL) + CW_SGATE; F.fillq = (unsigned*)(ws + WS_CTL) + CW_FILL; \
    F.POOLW = (bf16_t*)(ws + WS_POOLW); F.SGUW = (bf16_t*)(ws + WS_SGUW); F.WIN = (bf16_t*)(ws + WS_WIN); F.WOUT = (bf16_t*)(ws + WS_WOUT); F.WGU = (bf16_t*)(ws + WS_WGU); F.WDN = (bf16_t*)(ws + WS_WDN); \
    F.HB = (bf16_t*)(ws + WS_HB); F.PB = (bf16_t*)(ws + WS_PB); F.MIX = (bf16_t*)(ws + WS_MIX); F.ACT = (bf16_t*)(ws + WS_ACT); F.SB = (bf16_t*)(ws + WS_SB); \
    DUMH = (float*)(ws + WS_DUMH); DUMHB = (bf16_t*)(ws + WS_DUMHB); DUMSSQ = (float*)(ws + WS_DUMSSQ); }
#define IN(k) (lo <= (k) && (k) < hi)
#define SEAM(k) do { if (IN(k) && IN((k) + 1)) { unsigned long long ra_ = 0; const bool pb_ = (PROBE_CLK == 8 || PROBE_CLK == 9) && (k) == PROBE_SEAM; if (pb_ && opaque_tid() == 0) ra_ = __builtin_amdgcn_s_memrealtime(); \
    xcd_barrier(bar); for (int xb_ = 0; xb_ < PROBE_XBAR; ++xb_) xcd_barrier(bar); \
    if (pb_ && opaque_tid() == 0) { const unsigned dt_ = (unsigned)(__builtin_amdgcn_s_memrealtime() - ra_); unsigned* cw_ = (unsigned*)args.ws + 8000; atomicMax(cw_ + 5, dt_); atomicMax(cw_ + 6, 100000u - dt_); } } } while (0)
#define REPS(t) ((PROBE_DUP == (t)) ? 2 : 1)
#define REP_BAR(t) do { if (rep + 1 < REPS(t)) xcd_barrier(bar); } while (0)
template <int l>
DI void run_layer(const Args& args, LAS unsigned char* const lds_, const XcdBarrier& bar, const int lo, const int hi) {
    float* DUMH; bf16_t* DUMHB; float* DUMSSQ;
        const int p = 1 + 7 * l;
        if (IN(p)) for (int rep = 0; rep < REPS(1); ++rep) { MKFRAME();
            if (l > 0 && rep + 1 == REPS(1)) {
                for (int r = F.bid; r < NS; r += F.G) {
                    sample_finalize<true, false>(F.SPART, r, nullptr, F.HB + (size_t)MPR * D, nullptr, F.HB + (size_t)MPR * D, F.SSQS1);
                    asm volatile("s_waitcnt vmcnt(0)" ::: "memory"); __syncthreads();
                    if (opaque_tid() == 0) { __builtin_amdgcn_fence(__ATOMIC_RELEASE, "agent"); asm volatile("s_waitcnt vmcnt(0)" ::: "memory"); __hip_atomic_fetch_add(F.sgate, 1u, __ATOMIC_RELAXED, __HIP_MEMORY_SCOPE_AGENT); } }
            }
            pg8::Gemm g{F.HB, F.WIN + (size_t)l * INW * KPD, MP, INW, D, D, KPD}; pg8::GatedOrder S; S.init(MP, INW, F.G, opaque_sgpr(F.bid)); S.cnt = F.sgate; S.need = (l > 0 && rep + 1 == REPS(1)) ? (unsigned)NS : 0u;
            pg8::EpiIn E{F.PB, F.SSQ1, F.SSQS1};
            unsigned long long pr0_ = 0; if ((PROBE_CLK == 10 || PROBE_CLK == 12) && l == 0 && opaque_tid() == 0) pr0_ = __builtin_amdgcn_s_memrealtime();
            pg8::gemm_phase<pg8::EpiIn, pg8::GatedOrder, true, true>(F.lds, F.misc, g, S, E);
            if ((PROBE_CLK == 10 || PROBE_CLK == 12) && l == 0 && opaque_tid() == 0) { const unsigned d_ = (unsigned)(__builtin_amdgcn_s_memrealtime() - pr0_); atomicMax((unsigned*)args.ws + 8007, d_ * 256u + (unsigned)F.bid); }
            if (FILL_MODE == 1) hole_fill(F, (MP / 256) * (INW / 256) - 2 * F.G, HF_IN, l, WO_OUT, WO_DN);
            REP_BAR(1);
        } SEAM(p);
        if (IN(p + 1)) for (int rep = 0; rep < REPS(2); ++rep) { MKFRAME();
            const int NJ = 256 + 512 + 128;
            for (int j = F.bid; j < NJ; j += F.G) {
                if (j < 256) { ret_kv_unit(F, j >> 6, (j >> 4) & 3, j & 15); if (PROBE_UNIT == 1) ret_kv_unit(F, j >> 6, (j >> 4) & 3, j & 15); }
                else if (j < 768) { const int k = j - 256; sret_unit(F, l, k >> 2, k & 3); if (PROBE_UNIT == 2) sret_unit(F, l, k >> 2, k & 3); }
                else { smisc_unit(F, l, j - 768); if (PROBE_UNIT == 3) smisc_unit(F, l, j - 768); }
            }
            conv_flat(F, l); if (PROBE_UNIT == 4) conv_flat(F, l);
            REP_BAR(2);
        } SEAM(p + 1);
        if (IN(p + 2)) for (int rep = 0; rep < REPS(3); ++rep) { MKFRAME();
            ret_scan_flat(F, l); if (PROBE_UNIT == 5) ret_scan_flat(F, l);
            const int NJ = 512;
            for (int j = F.bid; j < NJ; j += F.G) {
                if (j < 256) { pool_unit(F, l, j >> 6, (j >> 2) & 15, j & 3); if (PROBE_UNIT == 6) pool_unit(F, l, j >> 6, (j >> 2) & 15, j & 3); }
                else { const int k = j - 256; sgu_unit(F, l, k >> 6, (k >> 2) & 15, k & 3); if (PROBE_UNIT == 7) sgu_unit(F, l, k >> 6, (k >> 2) & 15, k & 3); }
            }
            __syncthreads();
            REP_BAR(3);
        } SEAM(p + 2);
        if (IN(p + 3)) for (int rep = 0; rep < REPS(4); ++rep) { MKFRAME();
            const bool dm = rep + 1 < REPS(4);
            for (int j = F.bid; j < 256; j += F.G) { ret_out_unit(F, l, j >> 6, (j >> 4) & 3, j & 15); if (PROBE_UNIT == 8) ret_out_unit(F, l, j >> 6, (j >> 4) & 3, j & 15); }
            for (int rp = 0; rp < (PROBE_UNIT == 9 ? 2 : 1); ++rp)
            for (int j = F.bid; j < 256; j += F.G) skinny_splitk_piece<D / 8>(F.lds, F.MIX + (size_t)MPR * D, D, F.WOUT + (size_t)l * D * KPD, KPD, j, F.SPART);
            __syncthreads();
            REP_BAR(4);
        } SEAM(p + 3);
        if (IN(p + 4)) for (int rep = 0; rep < REPS(5); ++rep) { MKFRAME();
            const bool dm = rep + 1 < REPS(5);
            pg8::Gemm g{F.MIX, F.WOUT + (size_t)l * D * KPD, MPR, D, D, D, KPD}; pg8::StaticOrder S; S.init(MPR, D, F.G, opaque_sgpr(F.bid));
            for (int r = F.bid; r < NS; r += F.G)
                sample_finalize<(l > 0), false>(F.SPART, r, F.xs, F.HB + (size_t)MPR * D, nullptr, (dm ? DUMHB : F.HB) + (size_t)MPR * D, dm ? DUMSSQ : F.SSQS2);
            typedef pg8::EpiRes<(l > 0), false> EpiOut;
            EpiOut E{F.xp, F.HB, nullptr, dm ? DUMHB : F.HB, dm ? DUMSSQ : F.SSQ2};
            pg8::gemm_phase<EpiOut, pg8::StaticOrder, true, true>(F.lds, F.misc, g, S, E);
            REP_BAR(5);
        } SEAM(p + 4);
        if (PROBE_CLK && l == 0 && opaque_tid() == 0) { LAS unsigned long long* cp = (LAS unsigned long long*)(lds_ + LDSCTL_OFF + 128); cp[0] = __builtin_amdgcn_s_memtime(); cp[1] = __builtin_amdgcn_s_memrealtime(); }
        if (IN(p + 5)) for (int rep = 0; rep < REPS(6); ++rep) { MKFRAME();
            pg8::Gemm g{F.HB, F.WGU + (size_t)l * GU * KPD, MP, GU, D, D, KPD}; pg8::StaticOrder S; S.init(MP, GU, F.G, opaque_sgpr(F.bid));
            if (PROBE_VAR == 5 && rep + 1 < REPS(6)) { S.hh_all = 0; pg8::EpiNull E0; pg8::gemm_phase<pg8::EpiNull, pg8::StaticOrder, true, true>(F.lds, F.misc, g, S, E0); S.hh_all = -1; }
            else if (PROBE_VAR == 1 && rep + 1 < REPS(6)) { pg8::EpiNull E0; pg8::gemm_phase<pg8::EpiNull, pg8::StaticOrder, true, true>(F.lds, F.misc, g, S, E0); }
            else if (PROBE_VAR >= 2 && PROBE_VAR <= 4 && rep + 1 < REPS(6)) { pg8::EpiGuT<PROBE_VAR> E2{(bf16_t*)DUMH, F.SSQ2, F.SSQS2}; pg8::gemm_phase<pg8::EpiGuT<PROBE_VAR>, pg8::StaticOrder, true, true>(F.lds, F.misc, g, S, E2); }
            else {
            pg8::EpiGu E{F.ACT, F.SSQ2, F.SSQS2};
            unsigned long long pr0_ = 0; if ((PROBE_CLK == 11 || PROBE_CLK == 13) && l == 0 && opaque_tid() == 0) pr0_ = __builtin_amdgcn_s_memrealtime();
            pg8::gemm_phase<pg8::EpiGu, pg8::StaticOrder, true, true>(F.lds, F.misc, g, S, E);
            if ((PROBE_CLK == 11 || PROBE_CLK == 13) && l == 0 && opaque_tid() == 0) { const unsigned d_ = (unsigned)(__builtin_amdgcn_s_memrealtime() - pr0_); atomicMax((unsigned*)args.ws + 8007, d_ * 256u + (unsigned)F.bid); }
            }
            if (FILL_MODE == 1) hole_fill(F, (MP / 256) * (GU / 256) - 5 * F.G, HF_GU, l, WO_DN, WI_L);
            if (FILL_MODE == 1 && l + 1 < DEPTH) hole_fill(F, (MP / 256) * (GU / 256) - 5 * F.G, HF_GU - WI_DN, l + 1, 0, WO_OUT);
            REP_BAR(6);
        }
        if (PROBE_CLK && l == 0 && opaque_tid() == 0) { const unsigned long long t1 = __builtin_amdgcn_s_memtime(), r1 = __builtin_amdgcn_s_memrealtime();
            LAS unsigned long long* cp = (LAS unsigned long long*)(lds_ + LDSCTL_OFF + 128); const unsigned long long clk_t0 = cp[0], clk_r0 = cp[1];
            const float ghz = (float)(t1 - clk_t0) / ((float)(r1 - clk_r0) * 10.0f); const unsigned dur = (unsigned)(r1 - clk_r0);
            unsigned* cw = (unsigned*)args.ws + 8000;
            atomicMax(cw + 0, dur); atomicMax(cw + 1, 100000u - dur); atomicAdd(cw + 2, dur); atomicMax(cw + 3, (unsigned)(ghz * 1000.f)); atomicMax(cw + 4, 10000u - (unsigned)(ghz * 1000.f));
            if (blockIdx.x == 0) *(LAS float*)(lds_ + LDSCTL_OFF + 64) = (PROBE_CLK == 1) ? 0.15f + (ghz - 1.0f) * 0.5f : 0.15f + (float)dur * 1e-5f; }
        SEAM(p + 5);
        if (IN(p + 6)) for (int rep = 0; rep < REPS(7); ++rep) { MKFRAME();
            const bool dm = rep + 1 < REPS(7);
            pg8::Gemm g{F.ACT, F.WDN + (size_t)l * D * KPF, MPR, D, FF, FF, KPF}; pg8::StaticOrder S; S.init(MPR, D, F.G, opaque_sgpr(F.bid));
            typedef pg8::EpiRes<true, false> EpiDown;
            EpiDown E{nullptr, F.HB, dm ? DUMH : F.H, dm ? DUMHB : F.HB, dm ? DUMSSQ : F.SSQ1};
            pg8::gemm_phase<EpiDown, pg8::StaticOrder, true, true>(F.lds, F.misc, g, S, E);
            for (int rp = 0; rp < (PROBE_UNIT == 10 ? 2 : 1); ++rp)
            for (int j = F.bid; j < 256; j += F.G)
                skinny_splitk_piece<FF / 8>(F.lds, F.ACT + (size_t)MPR * FF, FF, F.WDN + (size_t)l * D * KPF, KPF, j, F.SPART);
            __syncthreads();
            REP_BAR(7);
        } SEAM(p + 6);
}

__global__ void __launch_bounds__(512, 2) mk_fwd(Args args) {
    extern __shared__ __attribute__((aligned(16))) unsigned char lds[];
    float* DUMH; bf16_t* DUMHB; float* DUMSSQ;
    unsigned char* const ws = args.ws; LAS unsigned char* const lds_ = (LAS unsigned char*)lds;
    for (int u = threadIdx.x; u < (LDS_BYTES - LDSCTL_OFF) / 4; u += 512) ((LAS unsigned*)(lds_ + LDSCTL_OFF))[u] = 0u;
    __syncthreads();
    XcdBarrier bar; bar.bar = (unsigned*)(ws + WS_CTL) + CW_BAR; bar.x = 0; bar.st = nullptr;
    if (MK_N_LAUNCHES == 1) bar = xcd_barrier_post((unsigned*)(ws + WS_CTL) + CW_BAR, (volatile LAS unsigned*)(lds_ + LDSCTL_OFF));
    const int lo = args.ph_lo, hi = args.ph_hi;

    if (IN(0)) for (int rep = 0; rep < REPS(0); ++rep) { MKFRAME(); p0_prologue(F); REP_BAR(0); } SEAM(0);
    run_layer<0>(args, lds_, bar, lo, hi);
    run_layer<1>(args, lds_, bar, lo, hi);
    static_assert(DEPTH == 2, "two layers written out");
    if (IN(N_PHASES - 1)) for (int rep = 0; rep < REPS(8); ++rep) { MKFRAME(); final_norm(F); REP_BAR(8); }
    if (PROBE_CLK && blockIdx.x == 0 && opaque_tid() == 0) { asm volatile("s_waitcnt vmcnt(0)" ::: "memory"); const unsigned* cw = (const unsigned*)args.ws + 8000; float v = *(LAS float*)(lds_ + LDSCTL_OFF + 64);
        if (PROBE_CLK == 3) v = 0.15f + (float)__hip_atomic_load(cw + 0, __ATOMIC_RELAXED, __HIP_MEMORY_SCOPE_AGENT) * 1e-5f;
        if (PROBE_CLK == 4) v = 0.15f + (float)(100000u - __hip_atomic_load(cw + 1, __ATOMIC_RELAXED, __HIP_MEMORY_SCOPE_AGENT)) * 1e-5f;
        if (PROBE_CLK == 5) v = 0.15f + (float)__hip_atomic_load(cw + 2, __ATOMIC_RELAXED, __HIP_MEMORY_SCOPE_AGENT) * (1e-5f / 256.f);
        if (PROBE_CLK == 8) v = 0.15f + (float)__hip_atomic_load(cw + 5, __ATOMIC_RELAXED, __HIP_MEMORY_SCOPE_AGENT) * 1e-4f;
        if (PROBE_CLK == 9) v = 0.15f + (float)(100000u - __hip_atomic_load(cw + 6, __ATOMIC_RELAXED, __HIP_MEMORY_SCOPE_AGENT)) * 1e-4f;
        if (PROBE_CLK == 10 || PROBE_CLK == 11) v = 0.15f + (float)(__hip_atomic_load(cw + 7, __ATOMIC_RELAXED, __HIP_MEMORY_SCOPE_AGENT) & 255u) * 0.003f;
        if (PROBE_CLK == 12 || PROBE_CLK == 13) v = 0.15f + (float)(__hip_atomic_load(cw + 7, __ATOMIC_RELAXED, __HIP_MEMORY_SCOPE_AGENT) >> 8) * 1e-5f;
        if (PROBE_CLK == 6) v = 0.15f + ((float)__hip_atomic_load(cw + 3, __ATOMIC_RELAXED, __HIP_MEMORY_SCOPE_AGENT) * 1e-3f - 1.0f) * 0.5f;
        if (PROBE_CLK == 7) v = 0.15f + ((float)(10000u - __hip_atomic_load(cw + 4, __ATOMIC_RELAXED, __HIP_MEMORY_SCOPE_AGENT)) * 1e-3f - 1.0f) * 0.5f;
        args.out[O_YS] += v; }
#undef REPS
#undef REP_BAR
#undef MKFRAME
#undef IN
#undef SEAM
}

extern "C" void kernel_launch(void* const* d_in, const int* in_sizes, int n_in, void* d_out, int out_size, void* d_ws, size_t ws_size, hipStream_t stream) {
    static int grid = 0;
    if (grid == 0) {
        if (n_in != 19 || (size_t)out_size != O_END || ws_size < WS_END) { fprintf(stderr, "kernel_launch: unexpected sizes (n_in %d, out %d, ws %zu)\n", n_in, out_size, ws_size); grid = -1; return; }
        int dev = 0, cus = 0, per_cu = 0;
        if (hipGetDevice(&dev) != hipSuccess || hipDeviceGetAttribute(&cus, hipDeviceAttributeMultiprocessorCount, dev) != hipSuccess) { grid = -1; return; }
        if (hipFuncSetAttribute((const void*)mk_fwd, hipFuncAttributeMaxDynamicSharedMemorySize, LDS_BYTES) != hipSuccess) { fprintf(stderr, "kernel_launch: hipFuncSetAttribute failed\n"); grid = -1; return; }
        if (hipOccupancyMaxActiveBlocksPerMultiprocessor(&per_cu, (const void*)mk_fwd, 512, LDS_BYTES) != hipSuccess || per_cu < 1) { fprintf(stderr, "kernel_launch: occupancy query says %d blocks per CU\n", per_cu); per_cu = 1; }
        (void)hipGetLastError();
        grid = cus;
    }
    if (grid < 0) return;
    (void)hipMemsetAsync((char*)d_ws + WS_CTL, 0, CTL_ZERO_BYTES, stream);
    Args a{};
    for (int i = 0; i < 19; ++i) a.in[i] = (const float*)d_in[i];
    a.out = (float*)d_out; a.ws = (unsigned char*)d_ws;
    if (MK_N_LAUNCHES == 1) { a.ph_lo = 0; a.ph_hi = N_PHASES; a.li = 0; hipLaunchKernelGGL(mk_fwd, dim3(grid), dim3(512), LDS_BYTES, stream, a); }
    else for (int li = 0; li < N_PHASES; ++li) { a.ph_lo = li; a.ph_hi = li + 1; a.li = li; hipLaunchKernelGGL(mk_fwd, dim3(grid), dim3(512), LDS_BYTES, stream, a); }
}
```
